# Optimizing an MI355X kernel written in HIP

```python
import math
import jax, jax.numpy as jnp
from jax import lax
import numpy as np

D_MODEL = 1024
BATCH = 8
SEQ = 4096
DEPTH = 4

HEAD_DIM = 64
N_HEADS = D_MODEL // HEAD_DIM
A_KV_HEADS = 4
A_GROUP = N_HEADS // A_KV_HEADS
A_WINDOW = 128
A_BLOCK = 128
B_BRANCHES = ((128, 1), (512, 4), (2048, 16))
GRID_W = 64
NA_ROWS = 8
NA_COLS = 16
T5_BUCKETS = 32
T5_MAX_DIST = 1024
N_GROUPS = 4
EXPERTS_PER_GROUP = 8
N_EXPERTS = N_GROUPS * EXPERTS_PER_GROUP
TOP_K = 2
D_EXPERT = 512
MOE_BLOCK = 128
N_MIXERS = 3
ALPHA = (2 * DEPTH) ** 0.25
BETA = (8 * DEPTH) ** -0.25
LN_EPS = 1e-5
NEG_INF = -1e30

kernel_name = "hybrid_dilated_window_neighbourhood_hmoe_encoder"


def layer_norm(x, g, b):
    xf = x.astype(jnp.float32)
    mu = xf.mean(-1, keepdims=True)
    var = jnp.square(xf - mu).mean(-1, keepdims=True)
    return ((xf - mu) * lax.rsqrt(var + LN_EPS) * g.astype(jnp.float32) + b.astype(jnp.float32)).astype(x.dtype)


def t5_bucket(rel):
    half = T5_BUCKETS // 2
    exact = half // 2
    n = np.abs(rel)
    big = exact + (np.log(np.maximum(n, 1) / exact) / math.log(T5_MAX_DIST / exact) * (half - exact)).astype(np.int32)
    return ((rel > 0) * half + np.where(n < exact, n, np.minimum(big, half - 1))).astype(np.int32)


def relpos_bias(table, rel):
    b = jnp.take(table, jnp.asarray(t5_bucket(rel)), axis=0)
    return jnp.moveaxis(b, -1, 0).astype(jnp.float32)


def band_rel(blk):
    return (np.arange(3 * blk)[None, :] - blk) - np.arange(blk)[:, None]


def banded_attention(q, k, v, window, blk, bias, sink):
    n, length, kh, g, hd = q.shape
    nb = -(-length // blk)
    pad = nb * blk - length
    qb = jnp.pad(q, ((0, 0), (0, pad), (0, 0), (0, 0), (0, 0))).reshape(n, nb, blk, kh, g, hd)

    def band(t):
        t = jnp.pad(t, ((0, 0), (blk, blk + pad), (0, 0), (0, 0))).reshape(n, nb + 2, blk, kh, hd)
        return jnp.concatenate([t[:, :-2], t[:, 1:-1], t[:, 2:]], axis=2)

    kb, vb = band(k), band(v)
    s = jnp.einsum("nbqhgd,nbkhd->nbhgqk", qb, kb, preferred_element_type=jnp.float32) * hd ** -0.5
    rel = band_rel(blk)
    kpos = np.arange(nb)[:, None, None] * blk + (np.arange(3 * blk) - blk)[None, None, :]
    valid = (np.abs(rel) <= window)[None] & (kpos >= 0) & (kpos < length)
    s = jnp.where(valid[None, :, None, None], s + bias[None, None], NEG_INF)
    m = s.max(-1)
    if sink is not None:
        sk = sink.astype(jnp.float32)[None, None, :, :, None]
        m = jnp.maximum(m, sk)
    e = jnp.exp(s - m[..., None])
    den = e.sum(-1)
    if sink is not None:
        den = den + jnp.exp(sk - m)
    o = jnp.einsum("nbhgqk,nbkhd->nbqhgd", (e / den[..., None]).astype(v.dtype), vb)
    o = o.reshape(n, nb * blk, kh, g, hd)[:, :length]
    lse = (m + jnp.log(den)).transpose(0, 1, 4, 2, 3).reshape(n, nb * blk, kh, g)[:, :length]
    return o, lse


def mixer_a(x, w_qkv, sink, w_o, t5_table):
    bsz, s_len, _ = x.shape
    qkv = x @ w_qkv
    qw, kw = N_HEADS * HEAD_DIM, A_KV_HEADS * HEAD_DIM
    q = qkv[..., :qw].reshape(bsz, s_len, A_KV_HEADS, A_GROUP, HEAD_DIM)
    k = qkv[..., qw:qw + kw].reshape(bsz, s_len, A_KV_HEADS, HEAD_DIM)
    v = qkv[..., qw + kw:].reshape(bsz, s_len, A_KV_HEADS, HEAD_DIM)
    bias = relpos_bias(t5_table, band_rel(A_BLOCK)).reshape(A_KV_HEADS, A_GROUP, A_BLOCK, 3 * A_BLOCK)
    out, _ = banded_attention(q, k, v, A_WINDOW, A_BLOCK, bias, sink.reshape(A_KV_HEADS, A_GROUP))
    return out.reshape(bsz, s_len, qw) @ w_o


def to_residues(t, dil):
    bsz, s_len, h, hd = t.shape
    return t.reshape(bsz, s_len // dil, dil, h, hd).transpose(0, 2, 1, 3, 4).reshape(bsz * dil, s_len // dil, h, hd)


def from_residues(t, bsz, dil):
    sub = t.shape[1]
    t = t.reshape(bsz, dil, sub, *t.shape[2:])
    t = jnp.swapaxes(t, 1, 2)
    return t.reshape(bsz, sub * dil, *t.shape[3:])


def mixer_b(x, w_qkv, w_o, t5_table):
    bsz, s_len, _ = x.shape
    q, k, v = jnp.split(x @ w_qkv, 3, axis=-1)
    q = q.reshape(bsz, s_len, N_HEADS, HEAD_DIM)
    k = k.reshape(bsz, s_len, N_HEADS, HEAD_DIM)
    v = v.reshape(bsz, s_len, N_HEADS, HEAD_DIM)
    outs, lses = [], []
    for window, dil in B_BRANCHES:
        half = window // 2 // dil
        bias = relpos_bias(t5_table, band_rel(half) * dil)[:, None]
        o, lse = banded_attention(to_residues(q, dil)[:, :, :, None], to_residues(k, dil), to_residues(v, dil),
                                  half, half, bias, None)
        outs.append(from_residues(o[:, :, :, 0], bsz, dil))
        lses.append(from_residues(lse[:, :, :, 0], bsz, dil))
    wts = jax.nn.softmax(jnp.stack(lses), axis=0)
    mixed = jnp.einsum("nbsh,nbshd->bshd", wts, jnp.stack(outs).astype(jnp.float32))
    return mixed.astype(x.dtype).reshape(bsz, s_len, N_HEADS * HEAD_DIM) @ w_o


def mixer_c(x, w_qkv, rpb, w_o):
    bsz, s_len, _ = x.shape
    rows = s_len // GRID_W
    kr = min(NA_ROWS, rows)
    q, k, v = jnp.split(x @ w_qkv, 3, axis=-1)
    q = q.reshape(bsz, rows, GRID_W, N_HEADS, HEAD_DIM)
    k = k.reshape(bsz, rows, GRID_W, N_HEADS, HEAD_DIM)
    v = v.reshape(bsz, rows, GRID_W, N_HEADS, HEAD_DIM)
    ncb = GRID_W // NA_COLS
    qcol = np.arange(GRID_W).reshape(ncb, NA_COLS)
    win_start = np.clip(qcol - NA_COLS // 2, 0, GRID_W - NA_COLS)
    band_start = np.clip(np.arange(ncb) * NA_COLS - NA_COLS // 2, 0, GRID_W - 2 * NA_COLS)
    band_cols = band_start[:, None] + np.arange(2 * NA_COLS)
    col_ok = (band_cols[:, None, :] >= win_start[..., None]) & (band_cols[:, None, :] < win_start[..., None] + NA_COLS)
    col_idx = np.clip(band_cols[:, None, :] - qcol[..., None], 1 - NA_COLS, NA_COLS - 1) + NA_COLS - 1
    rpb_cols = rpb.astype(jnp.float32)[:, :, col_idx]
    scale = HEAD_DIM ** -0.5

    def row_attend(args):
        r, q_row = args
        start = jnp.clip(r - kr // 2, 0, rows - kr)
        kb = lax.dynamic_slice_in_dim(k, start, kr, axis=1)[:, :, band_cols]
        vb = lax.dynamic_slice_in_dim(v, start, kr, axis=1)[:, :, band_cols]
        qb = q_row.reshape(bsz, ncb, NA_COLS, N_HEADS, HEAD_DIM)
        s = jnp.einsum("bjqhd,brjkhd->bhjqrk", qb, kb, preferred_element_type=jnp.float32) * scale
        row_idx = start + jnp.arange(kr) - r + NA_ROWS - 1
        bias = jnp.take(rpb_cols, row_idx, axis=1).transpose(0, 2, 3, 1, 4)
        s = jnp.where(col_ok[None, None, :, :, None, :], s + bias[None], NEG_INF)
        p = jax.nn.softmax(s.reshape(*s.shape[:4], -1), axis=-1).reshape(s.shape)
        o = jnp.einsum("bhjqrk,brjkhd->bjqhd", p.astype(vb.dtype), vb)
        return o.reshape(bsz, GRID_W, N_HEADS, HEAD_DIM)

    out = lax.map(row_attend, (jnp.arange(rows), q.transpose(1, 0, 2, 3, 4)))
    return out.transpose(1, 0, 2, 3, 4).reshape(bsz, s_len, N_HEADS * HEAD_DIM) @ w_o


def hier_moe(h, rg_w, rg_b, re_w, re_b, w_gate, w_up, w_down):
    bsz, s_len, d = h.shape
    x2 = h.reshape(-1, d)
    n = x2.shape[0]
    lg = (x2 @ rg_w).astype(jnp.float32) + rg_b.astype(jnp.float32)
    grp = jnp.argmax(lg, axis=-1)
    p_grp = jnp.take_along_axis(jax.nn.softmax(lg, axis=-1), grp[:, None], axis=-1)
    le = (x2 @ re_w).astype(jnp.float32).reshape(n, N_GROUPS, EXPERTS_PER_GROUP) + re_b.astype(jnp.float32)
    le = jnp.take_along_axis(le, grp[:, None, None], axis=1)[:, 0]
    top_v, top_i = lax.top_k(le, TOP_K)
    gate = p_grp * jax.nn.softmax(top_v, axis=-1)
    expert = (grp[:, None] * EXPERTS_PER_GROUP + top_i).astype(jnp.int32)
    a = n * TOP_K
    flat_e = expert.reshape(a)
    flat_t = jnp.repeat(jnp.arange(n, dtype=jnp.int32), TOP_K)
    order = jnp.argsort(flat_e)
    se = flat_e[order]
    counts = jnp.bincount(flat_e, length=N_EXPERTS)
    padded = (counts + MOE_BLOCK - 1) // MOE_BLOCK * MOE_BLOCK
    pad_start = jnp.cumsum(padded) - padded
    seg_start = jnp.cumsum(counts) - counts
    dest = pad_start[se] + jnp.arange(a, dtype=jnp.int32) - seg_start[se]
    cap = a + N_EXPERTS * MOE_BLOCK
    slot_tok = jnp.full((cap,), n, jnp.int32).at[dest].set(flat_t[order])
    slot_w = jnp.zeros((cap,), jnp.float32).at[dest].set(gate.reshape(a)[order])
    nblk = cap // MOE_BLOCK
    blk_exp = jnp.minimum(jnp.searchsorted(pad_start + padded, jnp.arange(nblk, dtype=jnp.int32) * MOE_BLOCK,
                                           side="right"), N_EXPERTS - 1)
    xs = jnp.concatenate([x2, jnp.zeros((1, d), x2.dtype)])[slot_tok].reshape(nblk, MOE_BLOCK, d)

    def expert_block(args):
        xb, e = args
        return (jax.nn.silu(xb @ w_gate[e]) * (xb @ w_up[e])) @ w_down[e]

    ys = lax.map(expert_block, (xs, blk_exp)).reshape(cap, d)
    y = jax.ops.segment_sum(ys * slot_w[:, None].astype(ys.dtype), slot_tok, num_segments=n + 1)[:n]
    return y.reshape(bsz, s_len, d)


def setup_inputs(seed: int = 0) -> dict:
    key = jax.random.key(seed)
    keys = iter(jax.random.split(key, 16 * DEPTH + 4))

    def nrm(shape, scale):
        return jax.random.normal(next(keys), shape, jnp.float32) * scale

    d = D_MODEL
    inner = N_HEADS * HEAD_DIM
    inputs = {"x": nrm((BATCH, SEQ, d), 1.0), "t5_table": nrm((T5_BUCKETS, N_HEADS), 0.5)}
    for i in range(DEPTH):
        kind = i % N_MIXERS
        p = f"l{i}_"
        kv_width = A_KV_HEADS * HEAD_DIM if kind == 0 else inner
        inputs[p + "w_qkv"] = jnp.concatenate([nrm((d, inner), d ** -0.5), nrm((d, kv_width), d ** -0.5),
                                               nrm((d, kv_width), BETA * d ** -0.5)], axis=1)
        if kind == 0:
            inputs[p + "sink"] = nrm((N_HEADS,), 1.0)
        if kind == 2:
            inputs[p + "rpb"] = nrm((N_HEADS, 2 * NA_ROWS - 1, 2 * NA_COLS - 1), 0.5)
        inputs[p + "w_o"] = nrm((inner, d), BETA * inner ** -0.5)
        inputs[p + "ln1_g"] = 1.0 + nrm((d,), 0.02)
        inputs[p + "ln1_b"] = nrm((d,), 0.02)
        inputs[p + "rg_w"] = nrm((d, N_GROUPS), d ** -0.5)
        inputs[p + "rg_b"] = nrm((N_GROUPS,), 0.01)
        inputs[p + "re_w"] = nrm((d, N_EXPERTS), d ** -0.5)
        inputs[p + "re_b"] = nrm((N_GROUPS, EXPERTS_PER_GROUP), 0.01)
        inputs[p + "w_gate"] = nrm((N_EXPERTS, d, D_EXPERT), d ** -0.5)
        inputs[p + "w_up"] = nrm((N_EXPERTS, d, D_EXPERT), BETA * d ** -0.5)
        inputs[p + "w_down"] = nrm((N_EXPERTS, D_EXPERT, d), BETA * D_EXPERT ** -0.5)
        inputs[p + "ln2_g"] = 1.0 + nrm((d,), 0.02)
        inputs[p + "ln2_b"] = nrm((d,), 0.02)
    return inputs


def reference(x, t5_table,
              l0_w_qkv, l0_sink, l0_w_o, l0_ln1_g, l0_ln1_b, l0_rg_w, l0_rg_b, l0_re_w, l0_re_b,
              l0_w_gate, l0_w_up, l0_w_down, l0_ln2_g, l0_ln2_b,
              l1_w_qkv, l1_w_o, l1_ln1_g, l1_ln1_b, l1_rg_w, l1_rg_b, l1_re_w, l1_re_b,
              l1_w_gate, l1_w_up, l1_w_down, l1_ln2_g, l1_ln2_b,
              l2_w_qkv, l2_rpb, l2_w_o, l2_ln1_g, l2_ln1_b, l2_rg_w, l2_rg_b, l2_re_w, l2_re_b,
              l2_w_gate, l2_w_up, l2_w_down, l2_ln2_g, l2_ln2_b,
              l3_w_qkv, l3_sink, l3_w_o, l3_ln1_g, l3_ln1_b, l3_rg_w, l3_rg_b, l3_re_w, l3_re_b,
              l3_w_gate, l3_w_up, l3_w_down, l3_ln2_g, l3_ln2_b):
    mixer_args = [(l0_w_qkv, l0_sink, l0_w_o), (l1_w_qkv, l1_w_o),
                  (l2_w_qkv, l2_rpb, l2_w_o), (l3_w_qkv, l3_sink, l3_w_o)]
    norm1 = [(l0_ln1_g, l0_ln1_b), (l1_ln1_g, l1_ln1_b), (l2_ln1_g, l2_ln1_b), (l3_ln1_g, l3_ln1_b)]
    moe_args = [(l0_rg_w, l0_rg_b, l0_re_w, l0_re_b, l0_w_gate, l0_w_up, l0_w_down),
                (l1_rg_w, l1_rg_b, l1_re_w, l1_re_b, l1_w_gate, l1_w_up, l1_w_down),
                (l2_rg_w, l2_rg_b, l2_re_w, l2_re_b, l2_w_gate, l2_w_up, l2_w_down),
                (l3_rg_w, l3_rg_b, l3_re_w, l3_re_b, l3_w_gate, l3_w_up, l3_w_down)]
    norm2 = [(l0_ln2_g, l0_ln2_b), (l1_ln2_g, l1_ln2_b), (l2_ln2_g, l2_ln2_b), (l3_ln2_g, l3_ln2_b)]
    h = x
    for i in range(DEPTH):
        kind = i % N_MIXERS
        if kind == 0:
            y = mixer_a(h, *mixer_args[i], t5_table)
        elif kind == 1:
            y = mixer_b(h, *mixer_args[i], t5_table)
        else:
            y = mixer_c(h, *mixer_args[i])
        h = layer_norm(ALPHA * h + y, *norm1[i])
        h = layer_norm(ALPHA * h + hier_moe(h, *moe_args[i]), *norm2[i])
    return h
```

```cpp
#include <hip/hip_runtime.h>
#include <cstdio>
#include <cstdint>

#ifndef MK_N_LAUNCHES
#define MK_N_LAUNCHES 29
#endif

#define LAS __attribute__((address_space(3)))
#define GAS __attribute__((address_space(1)))
typedef unsigned short bf16;
typedef unsigned v4u __attribute__((ext_vector_type(4)));
typedef unsigned v2u __attribute__((ext_vector_type(2)));
typedef float f32x4 __attribute__((ext_vector_type(4)));
typedef float f32x2 __attribute__((ext_vector_type(2)));
typedef short bf16x8 __attribute__((ext_vector_type(8)));

constexpr int BATCH = 8, SEQ = 4096, D = 1024, H = 16, HD = 64, M = BATCH * SEQ;
constexpr int NEXP = 32, DEXP = 512, NLAYER = 4;
constexpr float LN_EPS = 1e-5f;
constexpr float ALPHA = 1.681792830507429f;
constexpr int NWAVES = 8;
constexpr int NPHASE = 1 + 7 * NLAYER;

constexpr size_t MiB = 1u << 20;
constexpr size_t WS_CTL = 0, CTL_ZERO_BYTES = 1 * MiB;
constexpr size_t WS_BIAS = 1 * MiB;
constexpr size_t WS_WQKV = 2 * MiB, WS_WO = 8 * MiB, WS_W1 = 10 * MiB, WS_W2 = 74 * MiB;
constexpr size_t WS_HB = 106 * MiB;
constexpr size_t WS_TOK2 = 170 * MiB;
constexpr size_t WS_TI = 174 * MiB;
constexpr size_t WS_Q = 176 * MiB, WS_K = 240 * MiB, WS_V = 304 * MiB, WS_AO = 368 * MiB;
constexpr size_t WS_Y = WS_Q;
constexpr size_t WS_ACT = 176 * MiB;
constexpr size_t WS_YS = 248 * MiB;
constexpr size_t WS_END = 432 * MiB;
constexpr int CW_TMO = 0, CW_CODE = 1, CW_BAR = 4096, CW_CNT = 16384;

constexpr int RING_OFF = 0, RING_BYTES = 131072;
constexpr int LDSCTL_OFF = RING_BYTES;
constexpr int MISC_OFF = LDSCTL_OFF + 320;
constexpr int TB_OFF = MISC_OFF + 128;
constexpr int CNT_OFF = TB_OFF + 160;
constexpr int LDS_BYTES = 147456;
static_assert(CNT_OFF + 128 <= LDS_BYTES, "LDS map");

#define RLX_AGENT __ATOMIC_RELAXED, __HIP_MEMORY_SCOPE_AGENT
#define LDS_WAIT() asm volatile("s_waitcnt lgkmcnt(0)" ::: "memory")
#define VM_WAIT() asm volatile("s_waitcnt vmcnt(0)" ::: "memory")
__device__ __forceinline__ unsigned f2bf(float f) { unsigned u = __builtin_bit_cast(unsigned, f); return (u + 0x7fffu + ((u >> 16) & 1u)) >> 16; }
__device__ __forceinline__ unsigned pk2(float lo, float hi) { return f2bf(lo) | (f2bf(hi) << 16); }
__device__ __forceinline__ float bflo(unsigned w) { return __builtin_bit_cast(float, w << 16); }
__device__ __forceinline__ float bfhi(unsigned w) { return __builtin_bit_cast(float, w & 0xffff0000u); }
__device__ __forceinline__ float wave_sum(float v) {
#pragma unroll
    for (int o = 1; o < 64; o <<= 1) v += __shfl_xor(v, o);
    return v;
}
__device__ __forceinline__ int t5_bucket(int rel) {
    const int n = rel < 0 ? -rel : rel;
    int b = n < 8 ? n : 8 + (n >= 15) + (n >= 27) + (n >= 50) + (n >= 91) + (n >= 166) + (n >= 305) + (n >= 559);
    return b + (rel > 0 ? 16 : 0);
}

namespace pg8 {
typedef unsigned short bf16_t;
typedef unsigned u32x4 __attribute__((ext_vector_type(4)));
constexpr int BM = 256, BK = 64, HALF = 128, HTB = HALF * BK * 2, STAGE_BYTES = 8 * HTB, NXCD = 8, WGM = 8;
__host__ __device__ __forceinline__ int lds_byte(int r, int c) { const int st = (r >> 4) * 2 + (c >> 5), rr = r & 15, cc = c & 31, ob = rr * 64 + cc * 2; return st * 1024 + (ob ^ (((ob >> 9) & 1) << 5)); }
__host__ __device__ __forceinline__ void stage_rc(int b, int& R, int& C) { const int st = b / 1024, sb = b % 1024, swz = sb ^ (((sb >> 9) & 1) << 5); R = (st >> 1) * 16 + swz / 64; C = (st & 1) * 32 + (swz % 64) / 2; }
__host__ __device__ __forceinline__ int perm32(int rho) { const int n = rho >> 4, i = rho & 15; return 8 * (i >> 2) + 4 * n + (i & 3); }

struct Unit { int pm, pn, e, r0, nv; };

struct StaticOrder {
    int nM, nN, nwg, G, c;
    __device__ __forceinline__ void init(int nM_, int nN_, int G_, int c_) { nM = nM_; nN = nN_; nwg = nM * nN; G = G_; c = c_; }
    __device__ __forceinline__ bool next(int i, Unit& u) const {
        const long L = (long)i * G + c; if (L >= nwg) return false;
        int wgid = (int)L; { const int q = nwg / NXCD, r = nwg % NXCD, xcd = wgid % NXCD, off = wgid / NXCD; wgid = (xcd < r ? xcd * (q + 1) : r * (q + 1) + (xcd - r) * q) + off; }
        const int nig = WGM * nN, gid = wgid / nig, fm = gid * WGM, gsz = (nM - fm) < WGM ? (nM - fm) : WGM;
        u.pm = fm + ((wgid % nig) % gsz); u.pn = (wgid % nig) / gsz; u.e = 0; u.r0 = 0; u.nv = 256; return true;
    }
};
struct MoeOrder {
    StaticOrder so; const LAS int* tb; const LAS int* cnt;
    __device__ __forceinline__ bool next(int i, Unit& u) const {
        if (!so.next(i, u)) return false;
        int e = 0;
#pragma unroll 1
        for (int j = 1; j < 32; ++j) e += (__builtin_amdgcn_readfirstlane(tb[j]) <= u.pm) ? 1 : 0;
        const int t0 = __builtin_amdgcn_readfirstlane(tb[e]), ce = __builtin_amdgcn_readfirstlane(cnt[e]);
        u.e = e; u.r0 = (u.pm - t0) * 256; u.nv = ce - u.r0; return true;
    }
};

__device__ __forceinline__ unsigned cvt_pk_bf16(float lo, float hi) { unsigned r; asm volatile("v_cvt_pk_bf16_f32 %0, %1, %2" : "=v"(r) : "v"(lo), "v"(hi)); return r; }

struct EpiQKV {
    static constexpr bool PERM = true;
    bf16_t *Q, *K, *V; int kvw; float qscale;
    __device__ __forceinline__ void operator()(const f32x4 (&acc)[2][2][4][2], const Unit& u, int wr, int wc, int fr, int fq) const {
        const int row0 = u.pm * BM + wr * 64 + fr; int colt = u.pn * BM; bf16_t* base; int ldc; float sc = 1.f;
        if (colt < 1024) { base = Q; ldc = 1024; sc = qscale; } else if (colt < 1024 + kvw) { base = K; ldc = kvw; colt -= 1024; } else { base = V; ldc = kvw; colt -= 1024 + kvw; }
        const int col0 = colt + wc * 32 + 8 * fq;
#pragma unroll
        for (int ai = 0; ai < 2; ++ai)
#pragma unroll
            for (int m = 0; m < 4; ++m) { bf16_t* rowp = base + (size_t)(row0 + ai * HALF + m * 16) * ldc + col0;
#pragma unroll
                for (int bj = 0; bj < 2; ++bj) { const f32x4 v0 = acc[ai][bj][m][0] * sc, v1 = acc[ai][bj][m][1] * sc;
                    u32x4 w; w.x = cvt_pk_bf16(v0[0], v0[1]); w.y = cvt_pk_bf16(v0[2], v0[3]); w.z = cvt_pk_bf16(v1[0], v1[1]); w.w = cvt_pk_bf16(v1[2], v1[3]);
                    *(u32x4*)(rowp + bj * HALF) = w; } }
    }
};
struct EpiPlain {
    static constexpr bool PERM = true;
    bf16_t* O; int ldc;
    __device__ __forceinline__ void operator()(const f32x4 (&acc)[2][2][4][2], const Unit& u, int wr, int wc, int fr, int fq) const {
        const int row0 = u.pm * BM + wr * 64 + fr; const int col0 = u.pn * BM + wc * 32 + 8 * fq;
#pragma unroll
        for (int ai = 0; ai < 2; ++ai)
#pragma unroll
            for (int m = 0; m < 4; ++m) { bf16_t* rowp = O + (size_t)(row0 + ai * HALF + m * 16) * ldc + col0;
#pragma unroll
                for (int bj = 0; bj < 2; ++bj) { const f32x4 v0 = acc[ai][bj][m][0], v1 = acc[ai][bj][m][1];
                    u32x4 w; w.x = cvt_pk_bf16(v0[0], v0[1]); w.y = cvt_pk_bf16(v0[2], v0[3]); w.z = cvt_pk_bf16(v1[0], v1[1]); w.w = cvt_pk_bf16(v1[2], v1[3]);
                    *(u32x4*)(rowp + bj * HALF) = w; } }
    }
};
__device__ __forceinline__ float silu_mul(float g, float u) { return g * u * __builtin_amdgcn_rcpf(1.0f + __builtin_amdgcn_exp2f(-1.4426950408889634f * g)); }
struct EpiSilu {
    static constexpr bool PERM = true;
    bf16_t* O;
    __device__ __forceinline__ void operator()(const f32x4 (&acc)[2][2][4][2], const Unit& u, int wr, int wc, int fr, int fq) const {
        const int row0 = u.pm * BM + wr * 64 + fr; const int col0 = u.pn * HALF + wc * 32 + 8 * fq;
#pragma unroll
        for (int ai = 0; ai < 2; ++ai)
#pragma unroll
            for (int m = 0; m < 4; ++m) { bf16_t* rowp = O + (size_t)(row0 + ai * HALF + m * 16) * 512 + col0;
                const f32x4 g0 = acc[ai][0][m][0], g1 = acc[ai][0][m][1], u0 = acc[ai][1][m][0], u1 = acc[ai][1][m][1];
                u32x4 w; w.x = cvt_pk_bf16(silu_mul(g0[0], u0[0]), silu_mul(g0[1], u0[1])); w.y = cvt_pk_bf16(silu_mul(g0[2], u0[2]), silu_mul(g0[3], u0[3]));
                w.z = cvt_pk_bf16(silu_mul(g1[0], u1[0]), silu_mul(g1[1], u1[1])); w.w = cvt_pk_bf16(silu_mul(g1[2], u1[2]), silu_mul(g1[3], u1[3]));
                *(u32x4*)rowp = w; }
    }
};

template <class Epi, class Sched, bool GATHER, bool ALIGN_EPI>
__device__ __forceinline__ void gemm_phase(const int tid, LAS unsigned char* lds, const bf16_t* A, const bf16_t* Bt, const int K, const size_t estride, const int* toks, const Sched& S, const Epi& E) {
    const int wid = __builtin_amdgcn_readfirstlane(tid >> 6), lane = tid & 63, wr = wid >> 2, wc = wid & 3, fr = lane & 15, fq = lane >> 4;
    const int nt = K / BK;
    unsigned voffA[2], voffB[2];
#pragma unroll
    for (int i = 0; i < 2; ++i) { int R, C; stage_rc(tid * 16 + i * 8192, R, C); const int Rb = Epi::PERM ? ((R & ~31) + perm32(R & 31)) : R; voffA[i] = (unsigned)(R * K + C) * 2u; voffB[i] = (unsigned)(Rb * K + C) * 2u; }
    const size_t kstep = (size_t)(BK * 2);
    const size_t hstep = (size_t)HALF * K * 2;
    const size_t tstep = 2 * hstep;
    const unsigned ldsw = (unsigned)wid * 1024u;
    const int aoff = lds_byte(wr * 64 + fr, fq * 8), boff = lds_byte(wc * 32 + fr, fq * 8);
#define PG8_SA(b, h) (((b) * 2 + (h)) * HTB)
#define PG8_SB(b, h) ((4 + (b) * 2 + (h)) * HTB)
#define PG8_STAGE2(bufoff, gbase, v0, v1) do { \
        __builtin_amdgcn_global_load_lds((const unsigned*)((const char*)(gbase) + (v0)), (LAS unsigned*)(lds + (bufoff) + ldsw), 16, 0, 0); \
        __builtin_amdgcn_global_load_lds((const unsigned*)((const char*)(gbase) + (v1)), (LAS unsigned*)(lds + (bufoff) + ldsw + 8192), 16, 0, 0); } while (0)
#define PG8_STAGE_B(bufoff, gbase) PG8_STAGE2(bufoff, gbase, voffB[0], voffB[1])
#define PG8_STAGE_A(bufoff, gbase, vo, h) do { if constexpr (GATHER) { PG8_STAGE2(bufoff, gbase, vo[h][0], vo[h][1]); } else { PG8_STAGE2(bufoff, (gbase) + (h) * hstep, voffA[0], voffA[1]); } } while (0)
#define PG8_LDA(dst, b, h) do { _Pragma("unroll") for (int m = 0; m < 4; ++m) _Pragma("unroll") for (int k = 0; k < 2; ++k) dst[m][k] = *(const LAS bf16x8*)(lds + PG8_SA(b, h) + aoff + m * 2048 + k * 1024); } while (0)
#define PG8_LDB(dst, b, h) do { _Pragma("unroll") for (int n = 0; n < 2; ++n) _Pragma("unroll") for (int k = 0; k < 2; ++k) dst[n][k] = *(const LAS bf16x8*)(lds + PG8_SB(b, h) + boff + n * 2048 + k * 1024); } while (0)
#define PG8_MMA(ai, bj, At, Bt_) do { __builtin_amdgcn_s_setprio(1); _Pragma("unroll") for (int m = 0; m < 4; ++m) _Pragma("unroll") for (int n = 0; n < 2; ++n) _Pragma("unroll") for (int k = 0; k < 2; ++k) \
        acc[ai][bj][m][n] = __builtin_amdgcn_mfma_f32_16x16x32_bf16(Bt_[n][k], At[m][k], acc[ai][bj][m][n], 0, 0, 0); __builtin_amdgcn_s_setprio(0); } while (0)
#define PG8_WAIT_V(n) asm volatile("s_waitcnt vmcnt(" #n ")" ::: "memory")
#define PG8_WAIT_L(n) asm volatile("s_waitcnt lgkmcnt(" #n ")" ::: "memory")
#define PG8_BAR __builtin_amdgcn_s_barrier()
#define PG8_SCHED __builtin_amdgcn_sched_barrier(0)
#define PG8_MKVO(u, vo) do { if constexpr (GATHER) { _Pragma("unroll") for (int h_ = 0; h_ < 2; ++h_) _Pragma("unroll") for (int i_ = 0; i_ < 2; ++i_) { int R_, C_; stage_rc(tid * 16 + i_ * 8192, R_, C_); \
        const int rl_ = h_ * HALF + R_; int tok_ = 0; if (rl_ < (u).nv) tok_ = toks[(size_t)(u).e * 32768 + (u).r0 + rl_]; vo[h_][i_] = (unsigned)tok_ * (unsigned)(K * 2) + (unsigned)(C_ * 2); } } } while (0)
#define PG8_BASEA(u) (GATHER ? (const char*)A : (const char*)A + (size_t)(u).pm * tstep)
#define PG8_BASEB(u) ((const char*)Bt + ((size_t)(u).e * estride) * 2 + (size_t)(u).pn * tstep)
    Unit cur, nxt; int ui = 0;
    if (!S.next(0, cur)) return;
    f32x4 acc[2][2][4][2];
#pragma unroll
    for (int a = 0; a < 2; ++a)
#pragma unroll
        for (int b = 0; b < 2; ++b)
#pragma unroll
            for (int m = 0; m < 4; ++m)
#pragma unroll
                for (int n = 0; n < 2; ++n) acc[a][b][m][n] = (f32x4){0.f, 0.f, 0.f, 0.f};
    bf16x8 At[4][2], B0[2][2], B1[2][2];
    unsigned cvo[2][2], nvo[2][2];
    PG8_MKVO(cur, cvo);
    const char* cA = PG8_BASEA(cur); const char* cB = PG8_BASEB(cur);
    PG8_STAGE_B(PG8_SB(0, 0), cB); PG8_STAGE_B(PG8_SB(0, 1), cB + hstep); PG8_STAGE_A(PG8_SA(0, 0), cA, cvo, 0); PG8_STAGE_A(PG8_SA(0, 1), cA, cvo, 1);
    if (wr == 1) PG8_BAR;
    PG8_WAIT_V(2); PG8_BAR;
    PG8_STAGE_B(PG8_SB(1, 0), cB + kstep); PG8_STAGE_A(PG8_SA(1, 0), cA + kstep, cvo, 0); PG8_STAGE_B(PG8_SB(1, 1), cB + hstep + kstep);
    PG8_WAIT_V(6); PG8_BAR;
    for (;;) {
        const bool has_next = S.next(ui + 1, nxt);
        const char* nA = cA; const char* nB = cB;
        if constexpr (GATHER) {
#pragma unroll
            for (int h_ = 0; h_ < 2; ++h_)
#pragma unroll
                for (int i_ = 0; i_ < 2; ++i_) nvo[h_][i_] = cvo[h_][i_];
        }
        if (has_next) { nA = PG8_BASEA(nxt); nB = PG8_BASEB(nxt); PG8_MKVO(nxt, nvo); }
        for (int t = 0; t < nt; t += 2) {
            const bool last = (t == nt - 2);
            const char* a1 = cA + (size_t)(t + 1) * kstep;
            const char* a2 = last ? nA : cA + (size_t)(t + 2) * kstep; const char* b2 = last ? nB : cB + (size_t)(t + 2) * kstep;
            const char* a3 = a2 + kstep; const char* b3 = b2 + kstep;
            unsigned svo[2][2];
            if constexpr (GATHER) {
#pragma unroll
                for (int h_ = 0; h_ < 2; ++h_)
#pragma unroll
                    for (int i_ = 0; i_ < 2; ++i_) svo[h_][i_] = last ? nvo[h_][i_] : cvo[h_][i_];
            }
            PG8_LDB(B0, 0, 0); PG8_LDB(B1, 0, 1); PG8_SCHED; PG8_LDA(At, 0, 0); PG8_STAGE_A(PG8_SA(1, 1), a1, cvo, 1);
            PG8_WAIT_V(8); PG8_WAIT_L(0); PG8_BAR; PG8_MMA(0, 0, At, B0); PG8_MMA(0, 1, At, B1); PG8_BAR; PG8_SCHED;
            PG8_LDA(At, 0, 1); PG8_STAGE_B(PG8_SB(0, 0), b2); PG8_STAGE_B(PG8_SB(0, 1), b2 + hstep); PG8_STAGE_A(PG8_SA(0, 0), a2, svo, 0);
            PG8_WAIT_V(8); PG8_WAIT_L(0); PG8_BAR; PG8_MMA(1, 0, At, B0); PG8_MMA(1, 1, At, B1); PG8_BAR; PG8_SCHED;
            PG8_LDB(B0, 1, 0); PG8_LDB(B1, 1, 1); PG8_SCHED; PG8_LDA(At, 1, 0); PG8_STAGE_A(PG8_SA(0, 1), a2, svo, 1);
            PG8_WAIT_V(8); PG8_WAIT_L(0); PG8_BAR; PG8_MMA(0, 0, At, B0); PG8_MMA(0, 1, At, B1); PG8_BAR; PG8_SCHED;
            PG8_LDA(At, 1, 1); PG8_STAGE_B(PG8_SB(1, 0), b3); PG8_STAGE_B(PG8_SB(1, 1), b3 + hstep); PG8_STAGE_A(PG8_SA(1, 0), a3, svo, 0);
            PG8_WAIT_V(8); PG8_WAIT_L(0); PG8_BAR; PG8_MMA(1, 0, At, B0); PG8_MMA(1, 1, At, B1); PG8_BAR; PG8_SCHED;
        }
        if constexpr (ALIGN_EPI) { if (wr == 0) PG8_BAR; }
        E(acc, cur, wr, wc, fr, fq);
        if (!has_next) break;
#pragma unroll
        for (int a = 0; a < 2; ++a)
#pragma unroll
            for (int b = 0; b < 2; ++b)
#pragma unroll
                for (int m = 0; m < 4; ++m)
#pragma unroll
                    for (int n = 0; n < 2; ++n) acc[a][b][m][n] = (f32x4){0.f, 0.f, 0.f, 0.f};
        cur = nxt; cA = nA; cB = nB; ++ui;
        if constexpr (GATHER) {
#pragma unroll
            for (int h_ = 0; h_ < 2; ++h_)
#pragma unroll
                for (int i_ = 0; i_ < 2; ++i_) cvo[h_][i_] = nvo[h_][i_];
        }
        if constexpr (ALIGN_EPI) { if (wr == 1) PG8_BAR; }
    }
    PG8_WAIT_V(0);
    if constexpr (!ALIGN_EPI) { if (wr == 0) PG8_BAR; }
    PG8_BAR;
#undef PG8_SA
#undef PG8_SB
#undef PG8_STAGE2
#undef PG8_STAGE_A
#undef PG8_STAGE_B
#undef PG8_LDA
#undef PG8_LDB
#undef PG8_MMA
#undef PG8_WAIT_V
#undef PG8_WAIT_L
#undef PG8_BAR
#undef PG8_SCHED
#undef PG8_MKVO
#undef PG8_BASEA
#undef PG8_BASEB
}
}

#define XB_TMO      128
#define XB_XCNT(j)  (256  + 64 * (j))
#define XB_XSUB(j)  (1280 + 64 * (j))
#define XB_XGEN(j)  (2304 + 64 * (j))
#define XB_TOP      3328
#define XB_TOPGEN   3392
#define XCD_BAR_WORDS 3456
#define XB_SPIN_CAP (1u << 18)
__device__ __forceinline__ unsigned xb_ld(unsigned* p)              { return __hip_atomic_load(p, __ATOMIC_RELAXED, __HIP_MEMORY_SCOPE_AGENT); }
__device__ __forceinline__ unsigned xb_add(unsigned* p, unsigned v) { return __hip_atomic_fetch_add(p, v, __ATOMIC_RELAXED, __HIP_MEMORY_SCOPE_AGENT); }
__device__ __forceinline__ unsigned xb_xcc_id() { return (unsigned)__builtin_amdgcn_s_getreg((3 << 11) | 20) & 0xFu; }
#define XB_SPIN(cond, bar) do { unsigned _sp = 0; while (cond) { __builtin_amdgcn_s_sleep(1); \
    if ((++_sp & 255u) == 0u) { if (xb_ld(&(bar)[XB_TMO])) break; if (_sp > XB_SPIN_CAP) { atomicAdd(&(bar)[XB_TMO], 1u); break; } } } } while (0)
struct XcdBarrier { unsigned* bar; unsigned x; volatile LAS unsigned* st; };
__device__ __forceinline__ XcdBarrier xcd_barrier_post(unsigned* bar, volatile LAS unsigned* st) {
    XcdBarrier b; b.bar = bar; b.x = xb_xcc_id(); b.st = st;
    if (threadIdx.x == 0) (void)xb_add(&bar[XB_XCNT(b.x)], 1u);
    return b;
}
__device__ __forceinline__ void xcd_barrier_complete(unsigned* bar, unsigned x, unsigned& nloc, unsigned& nx) {
    const unsigned G = gridDim.x * gridDim.y * gridDim.z;
    unsigned sum, cnt, mine, sp = 0u;
    for (;;) {
        sum = 0u; cnt = 0u; mine = 0u;
#pragma unroll
        for (unsigned j = 0; j < 16; ++j) { const unsigned c = xb_ld(&bar[XB_XCNT(j)]); sum += c; cnt += (c > 0u) ? 1u : 0u; mine = (j == x) ? c : mine; }
        if (sum == G) break;
        __builtin_amdgcn_s_sleep(1);
        if ((++sp & 255u) == 0u) { if (xb_ld(&bar[XB_TMO])) break; if (sp > XB_SPIN_CAP) { atomicAdd(&bar[XB_TMO], 1u); break; } }
    }
    nloc = mine > 0u ? mine : 1u; nx = cnt > 0u ? cnt : 1u;
}
__device__ __forceinline__ void xcd_barrier(const XcdBarrier& b) {
    asm volatile("s_waitcnt vmcnt(0)" ::: "memory");
    __syncthreads();
    if (threadIdx.x == 0) {
        unsigned* bar = b.bar;
        __builtin_amdgcn_s_waitcnt(0);
        unsigned nloc = b.st[0], nx = b.st[1];
        if (nloc == 0u) { xcd_barrier_complete(bar, b.x, nloc, nx); b.st[0] = nloc; b.st[1] = nx; }
        const unsigned old = xb_add(&bar[XB_XSUB(b.x)], 1u);
        const unsigned gen = old / nloc;
        if (old + 1u == (gen + 1u) * nloc) {
            __builtin_amdgcn_fence(__ATOMIC_RELEASE, "agent");
            asm volatile("s_waitcnt vmcnt(0)" ::: "memory");
            const unsigned og = xb_add(&bar[XB_TOP], 1u);
            const unsigned tg = og / nx;
            if (og + 1u == (tg + 1u) * nx) xb_add(&bar[XB_TOPGEN], 1u);
            else XB_SPIN(xb_ld(&bar[XB_TOPGEN]) == tg, bar);
            __builtin_amdgcn_fence(__ATOMIC_ACQUIRE, "agent");
            xb_add(&bar[XB_XGEN(b.x)], 1u);
            asm volatile("s_waitcnt vmcnt(0)" ::: "memory");
        } else {
            XB_SPIN(xb_ld(&bar[XB_XGEN(b.x)]) == gen, bar);
            __builtin_amdgcn_fence(__ATOMIC_ACQUIRE, "agent");
            asm volatile("s_waitcnt vmcnt(0)" ::: "memory");
        }
    }
    __syncthreads();
}

struct LayerP { const float *wqkv, *extra, *wo, *ln1g, *ln1b, *rgw, *rgb, *rew, *reb, *wg, *wu, *wd, *ln2g, *ln2b; };
struct Args { const float* x; const float* t5; LayerP L[NLAYER]; float* out; unsigned char* ws; int ph_lo, ph_hi, li, pad; };

__device__ __forceinline__ void transpose_item(const float* W, int K, int N, bf16* WT, int ilv, LAS float* scr, int item, int lane) {
    const int nblk = N / 32, kb = item / nblk, nb = item % nblk, k0 = 64 * kb, n0 = 32 * nb;
    const int rbase = ilv ? ((n0 >> 7) * 256 + (n0 & 127) + (ilv == 2 ? 128 : 0)) : n0;
#pragma unroll 8
    for (int i = 0; i < 32; ++i) { const int kk = 2 * i + (lane >> 5); scr[kk * 33 + (lane & 31)] = W[(size_t)(k0 + kk) * N + n0 + (lane & 31)]; }
    LDS_WAIT(); asm volatile("" ::: "memory");
    const int c = lane & 7;
#pragma unroll
    for (int j = 0; j < 4; ++j) { const int n = (lane >> 3) + 8 * j; const LAS float* s = scr + (8 * c) * 33 + n;
        v4u o; o.x = pk2(s[0 * 33], s[1 * 33]); o.y = pk2(s[2 * 33], s[3 * 33]); o.z = pk2(s[4 * 33], s[5 * 33]); o.w = pk2(s[6 * 33], s[7 * 33]);
        *(v4u*)(WT + (size_t)(rbase + n) * K + k0 + 8 * c) = o; }
    LDS_WAIT(); asm volatile("" ::: "memory");
}
__device__ __forceinline__ void convert_layer_weights(const LayerP& P, int nqkv, unsigned char* ws, LAS unsigned char* lds, int gw, int NGW, int wave, int lane) {
    LAS float* scr = (LAS float*)(lds + RING_OFF + wave * 16384);
    bf16* Wqkv_t = (bf16*)(ws + WS_WQKV); bf16* Wo_t = (bf16*)(ws + WS_WO); bf16* W1_t = (bf16*)(ws + WS_W1); bf16* W2_t = (bf16*)(ws + WS_W2);
    const int I_QKV = (D / 64) * (nqkv / 32), I_O = (D / 64) * (D / 32), I_G = (D / 64) * (DEXP / 32), I_D = (DEXP / 64) * (D / 32);
    const int I_E = 2 * I_G + I_D, NITEMS = I_QKV + I_O + NEXP * I_E;
    for (int it = gw; it < NITEMS; it += NGW) {
        int r = it;
        if (r < I_QKV) { transpose_item(P.wqkv, D, nqkv, Wqkv_t, 0, scr, r, lane); continue; } r -= I_QKV;
        if (r < I_O) { transpose_item(P.wo, D, D, Wo_t, 0, scr, r, lane); continue; } r -= I_O;
        const int e = r / I_E; r -= e * I_E;
        if (r < I_G) { transpose_item(P.wg + (size_t)e * D * DEXP, D, DEXP, W1_t + (size_t)e * D * D, 1, scr, r, lane); continue; } r -= I_G;
        if (r < I_G) { transpose_item(P.wu + (size_t)e * D * DEXP, D, DEXP, W1_t + (size_t)e * D * D, 2, scr, r, lane); continue; } r -= I_G;
        transpose_item(P.wd + (size_t)e * DEXP * D, DEXP, D, W2_t + (size_t)e * D * DEXP, 0, scr, r, lane);
    }
}

#define DOT8(s, qv, c, W4) do { s += qv[8 * (c) + 0] * bflo(W4[0]) + qv[8 * (c) + 1] * bfhi(W4[0]) + qv[8 * (c) + 2] * bflo(W4[1]) + qv[8 * (c) + 3] * bfhi(W4[1]) \
                                  + qv[8 * (c) + 4] * bflo(W4[2]) + qv[8 * (c) + 5] * bfhi(W4[2]) + qv[8 * (c) + 6] * bflo(W4[3]) + qv[8 * (c) + 7] * bfhi(W4[3]); } while (0)
#define AXPY8(ov, c, p, W4) do { ov[8 * (c) + 0] += p * bflo(W4[0]); ov[8 * (c) + 1] += p * bfhi(W4[0]); ov[8 * (c) + 2] += p * bflo(W4[1]); ov[8 * (c) + 3] += p * bfhi(W4[1]); \
                                 ov[8 * (c) + 4] += p * bflo(W4[2]); ov[8 * (c) + 5] += p * bfhi(W4[2]); ov[8 * (c) + 6] += p * bflo(W4[3]); ov[8 * (c) + 7] += p * bfhi(W4[3]); } while (0)
#define ATT_KEY(krow, vrow, biasv) do { \
        const v4u* kp_ = (const v4u*)(krow); float s_ = 0.f; \
        _Pragma("unroll") for (int c_ = 0; c_ < 8; ++c_) { const v4u w_ = kp_[c_]; DOT8(s_, q, c_, w_); } \
        s_ += (biasv); \
        if (s_ > m) { const float f_ = expf(m - s_); l *= f_; _Pragma("unroll") for (int d_ = 0; d_ < 64; ++d_) o[d_] *= f_; m = s_; } \
        const float p_ = expf(s_ - m); l += p_; \
        const v4u* vp_ = (const v4u*)(vrow); \
        _Pragma("unroll") for (int c_ = 0; c_ < 8; ++c_) { const v4u w_ = vp_[c_]; AXPY8(o, c_, p_, w_); } } while (0)
#define ATT_LOADQ(qrow) do { const v4u* qp_ = (const v4u*)(qrow); _Pragma("unroll") for (int c_ = 0; c_ < 8; ++c_) { const v4u w_ = qp_[c_]; \
        q[8 * c_ + 0] = bflo(w_.x); q[8 * c_ + 1] = bfhi(w_.x); q[8 * c_ + 2] = bflo(w_.y); q[8 * c_ + 3] = bfhi(w_.y); q[8 * c_ + 4] = bflo(w_.z); q[8 * c_ + 5] = bfhi(w_.z); q[8 * c_ + 6] = bflo(w_.w); q[8 * c_ + 7] = bfhi(w_.w); } \
        _Pragma("unroll") for (int d_ = 0; d_ < 64; ++d_) o[d_] = 0.f; } while (0)
#define ATT_STOREO(orow) do { const float rl_ = 1.0f / l; v4u* op_ = (v4u*)(orow); _Pragma("unroll") for (int c_ = 0; c_ < 8; ++c_) { v4u w_; \
        w_.x = pk2(o[8 * c_ + 0] * rl_, o[8 * c_ + 1] * rl_); w_.y = pk2(o[8 * c_ + 2] * rl_, o[8 * c_ + 3] * rl_); w_.z = pk2(o[8 * c_ + 4] * rl_, o[8 * c_ + 5] * rl_); w_.w = pk2(o[8 * c_ + 6] * rl_, o[8 * c_ + 7] * rl_); op_[c_] = w_; } } while (0)

__device__ __forceinline__ void attnA_naive(const bf16* Q, const bf16* Kb, const bf16* Vb, const float* sink, const float* biasT, bf16* AO, int gw, int NGW, int lane) {
    for (int wi = gw; wi < (M / 64) * H; wi += NGW) {
        const int h = wi & 15, t = (wi >> 4) * 64 + lane, b = t >> 12, pos = t & 4095, kvh = h >> 2;
        float q[64], o[64]; ATT_LOADQ(Q + (size_t)t * D + h * HD);
        float m = sink[h], l = 1.0f;
        const float* bh = biasT + h * 2049 + 1024;
        const int j0 = pos - 128 < 0 ? 0 : pos - 128, j1 = pos + 128 > SEQ - 1 ? SEQ - 1 : pos + 128;
        for (int j = j0; j <= j1; ++j) { const size_t kr = ((size_t)(b * SEQ + j)) * 256 + kvh * HD; ATT_KEY(Kb + kr, Vb + kr, bh[j - pos]); }
        ATT_STOREO(AO + (size_t)t * D + h * HD);
    }
}
__device__ __forceinline__ void attnB_naive(const bf16* Q, const bf16* Kb, const bf16* Vb, const float* biasT, bf16* AO, int gw, int NGW, int lane) {
    for (int wi = gw; wi < (M / 64) * H; wi += NGW) {
        const int h = wi & 15, t = (wi >> 4) * 64 + lane, b = t >> 12, pos = t & 4095;
        float q[64], o[64]; ATT_LOADQ(Q + (size_t)t * D + h * HD);
        float m = -1e30f, l = 0.0f;
        const float* bh = biasT + h * 2049 + 1024;
#pragma unroll 1
        for (int br = 0; br < 3; ++br) { const int dil = br == 0 ? 1 : br == 1 ? 4 : 16;
            for (int mm = -64; mm <= 64; ++mm) { const int j = pos + dil * mm; if (j < 0 || j >= SEQ) continue;
                const size_t kr = ((size_t)(b * SEQ + j)) * D + h * HD; ATT_KEY(Kb + kr, Vb + kr, bh[dil * mm]); } }
        ATT_STOREO(AO + (size_t)t * D + h * HD);
    }
}
__device__ __forceinline__ void attnC_naive(const bf16* Q, const bf16* Kb, const bf16* Vb, const float* rpb, bf16* AO, int gw, int NGW, int lane) {
    for (int wi = gw; wi < (M / 64) * H; wi += NGW) {
        const int h = wi & 15, t = (wi >> 4) * 64 + lane, b = t >> 12, pos = t & 4095, r = pos >> 6, c = pos & 63;
        float q[64], o[64]; ATT_LOADQ(Q + (size_t)t * D + h * HD);
        float m = -1e30f, l = 0.0f;
        const int rs = r - 4 < 0 ? 0 : (r - 4 > 56 ? 56 : r - 4), cs = c - 8 < 0 ? 0 : (c - 8 > 48 ? 48 : c - 8);
        const float* bh = rpb + h * (15 * 31);
#pragma unroll 1
        for (int rr = rs; rr < rs + 8; ++rr)
            for (int cc = cs; cc < cs + 16; ++cc) { int dc = cc - c; dc = dc < -15 ? -15 : (dc > 15 ? 15 : dc);
                const size_t kr = ((size_t)(b * SEQ + rr * 64 + cc)) * D + h * HD; ATT_KEY(Kb + kr, Vb + kr, bh[(rr - r + 7) * 31 + dc + 15]); }
        ATT_STOREO(AO + (size_t)t * D + h * HD);
    }
}

#define LN_STATS(v, mean, rstd) do { float s_ = 0.f; _Pragma("unroll") for (int j_ = 0; j_ < 4; ++j_) s_ += (v[j_].x + v[j_].y) + (v[j_].z + v[j_].w); \
        mean = wave_sum(s_) * (1.f / D); float s2_ = 0.f; \
        _Pragma("unroll") for (int j_ = 0; j_ < 4; ++j_) { const f32x4 d_ = v[j_] - mean; s2_ += (d_.x * d_.x + d_.y * d_.y) + (d_.z * d_.z + d_.w * d_.w); } \
        rstd = 1.0f / sqrtf(wave_sum(s2_) * (1.f / D) + LN_EPS); } while (0)

__device__ __forceinline__ void ln1_router_phase(const float* hin, const bf16* Y, const LayerP& P, float* hout, bf16* hb, unsigned* cntw, int* tok2, unsigned* ti, int gw, int NGW, int lane) {
    const f32x4* g4 = (const f32x4*)P.ln1g; const f32x4* b4 = (const f32x4*)P.ln1b;
    const f32x4* rgw4 = (const f32x4*)P.rgw;
    const f32x4* rew4 = (const f32x4*)P.rew;
    for (int t = gw; t < M; t += NGW) {
        f32x4 v[4];
#pragma unroll
        for (int j = 0; j < 4; ++j) { const f32x4 hv = ((const f32x4*)(hin + (size_t)t * D))[64 * j + lane]; const v2u yw = ((const v2u*)(Y + (size_t)t * D))[64 * j + lane];
            v[j].x = ALPHA * hv.x + bflo(yw.x); v[j].y = ALPHA * hv.y + bfhi(yw.x); v[j].z = ALPHA * hv.z + bflo(yw.y); v[j].w = ALPHA * hv.w + bfhi(yw.y); }
        float mean, rstd; LN_STATS(v, mean, rstd);
#pragma unroll
        for (int j = 0; j < 4; ++j) { v[j] = (v[j] - mean) * rstd * g4[64 * j + lane] + b4[64 * j + lane];
            ((f32x4*)(hout + (size_t)t * D))[64 * j + lane] = v[j];
            v2u w; w.x = pk2(v[j].x, v[j].y); w.y = pk2(v[j].z, v[j].w); ((v2u*)(hb + (size_t)t * D))[64 * j + lane] = w; }
        f32x4 lacc = {0.f, 0.f, 0.f, 0.f};
#pragma unroll
        for (int j = 0; j < 4; ++j)
#pragma unroll
            for (int c = 0; c < 4; ++c) lacc += rgw4[256 * j + 4 * lane + c] * v[j][c];
        float lg[4];
#pragma unroll
        for (int i = 0; i < 4; ++i) lg[i] = wave_sum(lacc[i]) + P.rgb[i];
        int grp = 0; float lmax = lg[0];
#pragma unroll
        for (int i = 1; i < 4; ++i) if (lg[i] > lmax) { lmax = lg[i]; grp = i; }
        float den = 0.f;
#pragma unroll
        for (int i = 0; i < 4; ++i) den += expf(lg[i] - lmax);
        const float pg = 1.0f / den;
        grp = __builtin_amdgcn_readfirstlane(grp);
        f32x4 ea0 = {0.f, 0.f, 0.f, 0.f}, ea1 = {0.f, 0.f, 0.f, 0.f};
#pragma unroll
        for (int j = 0; j < 4; ++j)
#pragma unroll
            for (int c = 0; c < 4; ++c) { const int d = 256 * j + 4 * lane + c; ea0 += rew4[d * 8 + grp * 2] * v[j][c]; ea1 += rew4[d * 8 + grp * 2 + 1] * v[j][c]; }
        float le[8];
#pragma unroll
        for (int i = 0; i < 4; ++i) { le[i] = wave_sum(ea0[i]) + P.reb[grp * 8 + i]; le[4 + i] = wave_sum(ea1[i]) + P.reb[grp * 8 + 4 + i]; }
        int i0 = 0; float v0 = le[0];
#pragma unroll
        for (int i = 1; i < 8; ++i) if (le[i] > v0) { v0 = le[i]; i0 = i; }
        int i1 = -1; float v1 = -3.0e38f;
#pragma unroll
        for (int i = 0; i < 8; ++i) if (i != i0 && le[i] > v1) { v1 = le[i]; i1 = i; }
        const float dd = expf(v1 - v0), g0 = pg / (1.0f + dd), g1 = pg * dd / (1.0f + dd);
        if (lane == 0) {
            const int e0 = grp * 8 + i0, e1 = grp * 8 + i1;
            const unsigned r0 = __hip_atomic_fetch_add(cntw + e0 * 32, 1u, RLX_AGENT), r1 = __hip_atomic_fetch_add(cntw + e1 * 32, 1u, RLX_AGENT);
            tok2[(size_t)e0 * 32768 + r0] = t; tok2[(size_t)e1 * 32768 + r1] = t;
            v4u a; a.x = (unsigned)e0; a.y = (unsigned)e1; a.z = r0; a.w = r1; ((v4u*)ti)[2 * t] = a;
            f32x2 gq; gq.x = g0; gq.y = g1; ((f32x2*)(ti + 8 * M))[t] = gq;
        }
    }
}
__device__ __forceinline__ void build_moe_tables(unsigned* cntw, LAS unsigned char* lds, int tid) {
    LAS int* tb = (LAS int*)(lds + TB_OFF); LAS int* cnt = (LAS int*)(lds + CNT_OFF);
    __syncthreads();
    if (tid < 32) cnt[tid] = (int)__hip_atomic_load(cntw + tid * 32, RLX_AGENT);
    __syncthreads();
    if (tid == 0) { int a = 0; for (int e = 0; e < 32; ++e) { tb[e] = a; a += (cnt[e] + 255) >> 8; } tb[32] = a; }
    __syncthreads();
}
__device__ __forceinline__ void ln2_combine_phase(float* hio, const bf16* YS, const LayerP& P, bf16* hb, const unsigned* ti, LAS unsigned char* lds, int gw, int NGW, int lane) {
    const LAS int* tb = (const LAS int*)(lds + TB_OFF);
    const f32x4* g4 = (const f32x4*)P.ln2g; const f32x4* b4 = (const f32x4*)P.ln2b;
    for (int t = gw; t < M; t += NGW) {
        const v4u a = ((const v4u*)ti)[2 * t]; const f32x2 gq = ((const f32x2*)(ti + 8 * M))[t];
        const int e0 = __builtin_amdgcn_readfirstlane((int)a.x), e1 = __builtin_amdgcn_readfirstlane((int)a.y);
        const size_t s0 = (size_t)tb[e0] * 256 + a.z, s1 = (size_t)tb[e1] * 256 + a.w;
        const float g0 = gq.x, g1 = gq.y;
        f32x4 v[4];
#pragma unroll
        for (int j = 0; j < 4; ++j) { const f32x4 hv = ((const f32x4*)(hio + (size_t)t * D))[64 * j + lane];
            const v2u y0 = ((const v2u*)(YS + s0 * D))[64 * j + lane], y1 = ((const v2u*)(YS + s1 * D))[64 * j + lane];
            v[j].x = ALPHA * hv.x + (g0 * bflo(y0.x) + g1 * bflo(y1.x)); v[j].y = ALPHA * hv.y + (g0 * bfhi(y0.x) + g1 * bfhi(y1.x));
            v[j].z = ALPHA * hv.z + (g0 * bflo(y0.y) + g1 * bflo(y1.y)); v[j].w = ALPHA * hv.w + (g0 * bfhi(y0.y) + g1 * bfhi(y1.y)); }
        float mean, rstd; LN_STATS(v, mean, rstd);
#pragma unroll
        for (int j = 0; j < 4; ++j) { v[j] = (v[j] - mean) * rstd * g4[64 * j + lane] + b4[64 * j + lane];
            ((f32x4*)(hio + (size_t)t * D))[64 * j + lane] = v[j];
            v2u w; w.x = pk2(v[j].x, v[j].y); w.y = pk2(v[j].z, v[j].w); ((v2u*)(hb + (size_t)t * D))[64 * j + lane] = w; }
    }
}


#ifndef MK_VERIFY
#define MK_VERIFY 0
#endif
__device__ __forceinline__ float bfr(float x) { return bflo(f2bf(x)); }
__device__ __forceinline__ float bfld(const bf16* p) { return bflo((unsigned)*p); }
__device__ __forceinline__ void vfail(unsigned* ctl, int code) { atomicMax(ctl + CW_CODE, (unsigned)(64 - code)); }
__device__ __forceinline__ bool vbad(float ref, float got) { return !(fabsf(ref - got) <= 0.02f * fabsf(ref) + 1e-3f); }

#if MK_VERIFY
constexpr size_t WS_SNAP = 448 * MiB;
__device__ __forceinline__ void verify_phase(const Args& args, int ph, unsigned char* ws, LAS unsigned char* lds, int tid, int bx) {
    unsigned* ctl = (unsigned*)(ws + WS_CTL);
    const float* biasT = (const float*)(ws + WS_BIAS); (void)biasT;
    const bf16* HB = (const bf16*)(ws + WS_HB); const bf16* QB = (const bf16*)(ws + WS_Q); const bf16* KB = (const bf16*)(ws + WS_K); const bf16* VB = (const bf16*)(ws + WS_V); const bf16* AO = (const bf16*)(ws + WS_AO);
    const bf16* YB = (const bf16*)(ws + WS_Y); const bf16* ACT = (const bf16*)(ws + WS_ACT); const bf16* YS = (const bf16*)(ws + WS_YS);
    const int* tok2 = (const int*)(ws + WS_TOK2); const unsigned* ti = (const unsigned*)(ws + WS_TI); const float* snap = (const float*)(ws + WS_SNAP);
    if (ph == 0) { if (bx == 0 && tid == 0) vfail(ctl, 40); return; }
    const int l = (ph - 1) / 7, s = (ph - 1) % 7, kind = (l == 1) ? 1 : (l == 2) ? 2 : 0;
    const int kvw = kind == 0 ? 256 : 1024, nqkv = 1024 + 2 * kvw;
    const LayerP& P = args.L[l];
    unsigned* cntw = ctl + CW_CNT + l * 32 * 32;
    const unsigned hs = (unsigned)(bx * 512 + tid) * 2654435761u + (unsigned)l * 977u + (unsigned)s * 131u;
    const int t = (int)(hs % (unsigned)M);
    if (s == 0) {
        const int n = (int)((hs >> 7) % (unsigned)nqkv);
        float a = 0.f; for (int k = 0; k < D; ++k) a += bfld(HB + (size_t)t * D + k) * bfr(P.wqkv[(size_t)k * nqkv + n]);
        float got; if (n < 1024) { a *= 0.125f; got = bfld(QB + (size_t)t * D + n); } else if (n < 1024 + kvw) got = bfld(KB + (size_t)t * kvw + (n - 1024)); else got = bfld(VB + (size_t)t * kvw + (n - 1024 - kvw));
        if (vbad(a, got)) vfail(ctl, l * 8 + 1);
    } else if (s == 1) {
        const int h = (int)((hs >> 7) & 15u), d = (int)((hs >> 11) & 63u), b = t >> 12, pos = t & 4095;
        const bf16* qr = QB + (size_t)t * D + h * HD;
        const int kh = kind == 0 ? (h >> 2) : h;
        const int nk = kind == 0 ? 257 : (kind == 1 ? 387 : 128);
        const int r = pos >> 6, c = pos & 63, rs = r - 4 < 0 ? 0 : (r - 4 > 56 ? 56 : r - 4), cs = c - 8 < 0 ? 0 : (c - 8 > 48 ? 48 : c - 8);
        float mx = kind == 0 ? P.extra[h] : -3.0e38f, den = 0.f, num = 0.f;
        for (int pass = 0; pass < 2; ++pass) {
            for (int i = 0; i < nk; ++i) {
                int j; float bias;
                if (kind == 0) { j = pos - 128 + i; bias = args.t5[t5_bucket(j - pos) * 16 + h]; }
                else if (kind == 1) { const int br = i / 129, mm = i % 129 - 64, dil = br == 0 ? 1 : (br == 1 ? 4 : 16); j = pos + dil * mm; bias = args.t5[t5_bucket(dil * mm) * 16 + h]; }
                else { const int rr = rs + i / 16, cc = cs + i % 16; int dc = cc - c; dc = dc < -15 ? -15 : (dc > 15 ? 15 : dc); j = rr * 64 + cc; bias = P.extra[h * 465 + (rr - r + 7) * 31 + dc + 15]; }
                if (j < 0 || j >= SEQ) continue;
                const bf16* kr = KB + ((size_t)(b * SEQ + j)) * kvw + kh * HD;
                float sc = 0.f; for (int e = 0; e < HD; ++e) sc += bfld(qr + e) * bfld(kr + e);
                sc += bias;
                if (pass == 0) mx = fmaxf(mx, sc);
                else { const float p = expf(sc - mx); den += p; num += p * bfld(VB + ((size_t)(b * SEQ + j)) * kvw + kh * HD + d); }
            }
            if (pass == 0 && kind == 0) den = expf(P.extra[h] - mx);
        }
        if (vbad(num / den, bfld(AO + (size_t)t * D + h * HD + d))) vfail(ctl, l * 8 + 2);
    } else if (s == 2) {
        const int n = (int)((hs >> 7) % (unsigned)D);
        float a = 0.f; for (int k = 0; k < D; ++k) a += bfld(AO + (size_t)t * D + k) * bfr(P.wo[(size_t)k * D + n]);
        if (vbad(a, bfld(YB + (size_t)t * D + n))) vfail(ctl, l * 8 + 3);
    } else if (s == 3 || s == 6) {
        const float* xin = (s == 3 && l == 0) ? args.x : snap;
        const float* gg = s == 3 ? P.ln1g : P.ln2g; const float* bb = s == 3 ? P.ln1b : P.ln2b;
        const v4u a4 = ((const v4u*)ti)[2 * t], b4 = ((const v4u*)ti)[2 * t + 1];
        const LAS int* tb = (const LAS int*)(lds + TB_OFF);
        const size_t s0 = (size_t)tb[a4.x & 31] * 256 + a4.z, s1 = (size_t)tb[a4.y & 31] * 256 + a4.w;
        const float g0 = __builtin_bit_cast(float, b4.x), g1 = __builtin_bit_cast(float, b4.y);
        float sum = 0.f;
        for (int d = 0; d < D; ++d) { const float y = s == 3 ? bfld(YB + (size_t)t * D + d) : (g0 * bfld(YS + s0 * D + d) + g1 * bfld(YS + s1 * D + d)); sum += ALPHA * xin[(size_t)t * D + d] + y; }
        const float mean = sum / D; float sq = 0.f;
        for (int d = 0; d < D; ++d) { const float y = s == 3 ? bfld(YB + (size_t)t * D + d) : (g0 * bfld(YS + s0 * D + d) + g1 * bfld(YS + s1 * D + d)); const float v = ALPHA * xin[(size_t)t * D + d] + y - mean; sq += v * v; }
        const float rstd = 1.0f / sqrtf(sq / D + LN_EPS);
        bool bad = false; float lg[4] = {0.f, 0.f, 0.f, 0.f};
        for (int d = 0; d < D; ++d) { const float y = s == 3 ? bfld(YB + (size_t)t * D + d) : (g0 * bfld(YS + s0 * D + d) + g1 * bfld(YS + s1 * D + d));
            const float o = (ALPHA * xin[(size_t)t * D + d] + y - mean) * rstd * gg[d] + bb[d]; const float got = args.out[(size_t)t * D + d];
            if (!(fabsf(o - got) <= 2e-3f)) bad = true; if (vbad(got, bfld(HB + (size_t)t * D + d))) bad = true;
            if (s == 3) { for (int i = 0; i < 4; ++i) lg[i] += got * P.rgw[d * 4 + i]; } }
        if (bad) vfail(ctl, l * 8 + (s == 3 ? 4 : 8));
        if (s == 3) {
            for (int i = 0; i < 4; ++i) lg[i] += P.rgb[i];
            int grp = 0; for (int i = 1; i < 4; ++i) if (lg[i] > lg[grp]) grp = i;
            float gap = 1e30f; for (int i = 0; i < 4; ++i) if (i != grp) gap = fminf(gap, lg[grp] - lg[i]);
            float den = 0.f; for (int i = 0; i < 4; ++i) den += expf(lg[i] - lg[grp]);
            const int e0 = (int)a4.x, e1 = (int)a4.y;
            bool rb = false;
            if ((e0 >> 3) != grp || (e1 >> 3) != grp) { if (gap > 1e-3f) { rb = true; } }
            else {
                float le[8]; for (int i = 0; i < 8; ++i) le[i] = 0.f;
                for (int d = 0; d < D; ++d) { const float got = args.out[(size_t)t * D + d]; for (int i = 0; i < 8; ++i) le[i] += got * P.rew[d * 32 + grp * 8 + i]; }
                for (int i = 0; i < 8; ++i) le[i] += P.reb[grp * 8 + i];
                int i0 = 0; for (int i = 1; i < 8; ++i) if (le[i] > le[i0]) i0 = i;
                int i1 = -1; for (int i = 0; i < 8; ++i) if (i != i0 && (i1 < 0 || le[i] > le[i1])) i1 = i;
                float third = -3e38f; for (int i = 0; i < 8; ++i) if (i != i0 && i != i1) third = fmaxf(third, le[i]);
                const bool near = (le[i1] - third < 1e-3f) || (le[i0] - le[i1] < 1e-3f);
                if ((e0 != grp * 8 + i0 || e1 != grp * 8 + i1) && !near) { rb = true; }
                if (l == 0) { unsigned msk = 0u; const float lk = __builtin_bit_cast(float, b4.z), vk = __builtin_bit_cast(float, b4.w);
                    msk |= lk == 64.f ? 1u : (lk == 128.f ? 2u : (lk == 32.f ? 4u : 8u));
                    msk |= vk == 2016.f ? 16u : (vk == 4032.f ? 32u : (vk == 1008.f ? 64u : 128u));
                    for (int q = 0; q < 8; ++q) if ((msk >> q) & 1u) atomicAdd(ctl + 4 + q, 1u); vfail(ctl, 5); }
            }
            if (e0 < 0 || e0 > 31 || e1 < 0 || e1 > 31 || e0 == e1) { rb = true; }
            if (tok2[(size_t)(e0 & 31) * 32768 + a4.z] != t || tok2[(size_t)(e1 & 31) * 32768 + a4.w] != t) { rb = true; }
            if (rb) vfail(ctl, l * 8 + 5);
        }
    } else if (s == 4) {
        const int ks = (int)((hs >> 5) & 1u), c = (int)((hs >> 7) % (unsigned)DEXP);
        const v4u a4 = ((const v4u*)ti)[2 * t]; const int e = (ks ? (int)a4.y : (int)a4.x) & 31, r = ks ? (int)a4.w : (int)a4.z;
        const size_t slot = (size_t)((const LAS int*)(lds + TB_OFF))[e] * 256 + r;
        float g = 0.f, u = 0.f; for (int k = 0; k < D; ++k) { const float xv = bfld(HB + (size_t)t * D + k); g += xv * bfr(P.wg[((size_t)e * D + k) * DEXP + c]); u += xv * bfr(P.wu[((size_t)e * D + k) * DEXP + c]); }
        const float ref = g / (1.0f + expf(-g)) * u;
        if (r < 0 || r >= ((const LAS int*)(lds + CNT_OFF))[e] || vbad(ref, bfld(ACT + slot * DEXP + c))) vfail(ctl, l * 8 + 6);
    } else if (s == 5) {
        const int ks = (int)((hs >> 5) & 1u), n = (int)((hs >> 7) % (unsigned)D);
        const v4u a4 = ((const v4u*)ti)[2 * t]; const int e = (ks ? (int)a4.y : (int)a4.x) & 31, r = ks ? (int)a4.w : (int)a4.z;
        const size_t slot = (size_t)((const LAS int*)(lds + TB_OFF))[e] * 256 + r;
        float a = 0.f; for (int c = 0; c < DEXP; ++c) a += bfld(ACT + slot * DEXP + c) * bfr(P.wd[((size_t)e * DEXP + c) * D + n]);
        if (vbad(a, bfld(YS + slot * D + n))) vfail(ctl, l * 8 + 7);
    }
    (void)cntw;
}
#endif
#ifndef PH_MASK
#define PH_MASK 0xff
#endif
#define PH_ON(k) (((PH_MASK) >> (k)) & 1)
__global__ void __launch_bounds__(NWAVES * 64, 2) mk_fwd(Args args) {
    extern __shared__ __attribute__((aligned(16))) unsigned char lds_raw[];
    LAS unsigned char* lds = (LAS unsigned char*)lds_raw;
    volatile LAS unsigned* MISC = (volatile LAS unsigned*)(lds + MISC_OFF);
    for (int u = threadIdx.x; u < (LDS_BYTES - LDSCTL_OFF) / 4; u += NWAVES * 64) ((LAS unsigned*)(lds + LDSCTL_OFF))[u] = 0u;
    __syncthreads();
    const int lo = args.ph_lo, hi = args.ph_hi;
    XcdBarrier bar; bar.bar = (unsigned*)(args.ws + WS_CTL) + CW_BAR; bar.x = 0; bar.st = nullptr;
    if (hi - lo > 1) bar = xcd_barrier_post((unsigned*)(args.ws + WS_CTL) + CW_BAR + args.li * XCD_BAR_WORDS, MISC + 8);

    for (int ph = lo; ph < hi; ++ph) {
        int tid = threadIdx.x; asm volatile("" : "+v"(tid));
        unsigned zoff = 0u; asm volatile("" : "+s"(zoff));
        unsigned char* ws = args.ws + zoff;
        int G = gridDim.x, bx = blockIdx.x; asm volatile("" : "+s"(G), "+s"(bx));
        const int lane = tid & 63, wave = __builtin_amdgcn_readfirstlane(tid >> 6);
        const int vcu = (G % 8 == 0) ? (bx % 8) * (G / 8) + bx / 8 : bx;
        const int gw = vcu * NWAVES + wave, NGW = G * NWAVES;
        unsigned* ctl = (unsigned*)(ws + WS_CTL);
        float* biasT = (float*)(ws + WS_BIAS);
        bf16* HB = (bf16*)(ws + WS_HB); bf16* QB = (bf16*)(ws + WS_Q); bf16* KB = (bf16*)(ws + WS_K); bf16* VB = (bf16*)(ws + WS_V); bf16* AO = (bf16*)(ws + WS_AO);
        bf16* YB = (bf16*)(ws + WS_Y); bf16* ACT = (bf16*)(ws + WS_ACT); bf16* YS = (bf16*)(ws + WS_YS);
        int* tok2 = (int*)(ws + WS_TOK2); unsigned* ti = (unsigned*)(ws + WS_TI);
        if (PH_ON(0) && ph == 0) {
            for (int i = bx * 512 + tid; i < 16 * 2049; i += G * 512) { const int h = i / 2049, rel = i % 2049 - 1024; biasT[i] = args.t5[t5_bucket(rel) * 16 + h]; }
            for (size_t i = (size_t)bx * 512 + tid; i < (size_t)M * D / 8; i += (size_t)G * 512) { const f32x4 a = ((const f32x4*)args.x)[2 * i], b = ((const f32x4*)args.x)[2 * i + 1];
                v4u w; w.x = pk2(a.x, a.y); w.y = pk2(a.z, a.w); w.z = pk2(b.x, b.y); w.w = pk2(b.z, b.w); ((v4u*)HB)[i] = w; }
            convert_layer_weights(args.L[0], 1536, ws, lds, gw, NGW, wave, lane);
        } else {
            const int l = (ph - 1) / 7, s = (ph - 1) % 7, kind = (l == 1) ? 1 : (l == 2) ? 2 : 0;
            const int kvw = kind == 0 ? 256 : 1024, nqkv = 1024 + 2 * kvw;
            const LayerP& P = args.L[l];
            unsigned* cntw = ctl + CW_CNT + l * 32 * 32;
            if (PH_ON(1) && s == 0) {
                pg8::StaticOrder S; S.init(M / 256, nqkv / 256, G, bx);
                pg8::EpiQKV E{QB, KB, VB, kvw, 0.125f};
                pg8::gemm_phase<pg8::EpiQKV, pg8::StaticOrder, false, true>(tid, lds + RING_OFF, HB, (const bf16*)(ws + WS_WQKV), D, 0, nullptr, S, E);
            } else if (PH_ON(2) && s == 1) {
                if (kind == 0) attnA_naive(QB, KB, VB, P.extra, biasT, AO, gw, NGW, lane);
                else if (kind == 1) attnB_naive(QB, KB, VB, biasT, AO, gw, NGW, lane);
                else attnC_naive(QB, KB, VB, P.extra, AO, gw, NGW, lane);
            } else if (PH_ON(3) && s == 2) {
                pg8::StaticOrder S; S.init(M / 256, D / 256, G, bx);
                pg8::EpiPlain E{YB, D};
                pg8::gemm_phase<pg8::EpiPlain, pg8::StaticOrder, false, true>(tid, lds + RING_OFF, AO, (const bf16*)(ws + WS_WO), D, 0, nullptr, S, E);
            } else if (PH_ON(4) && s == 3) {
                ln1_router_phase(l == 0 ? args.x : args.out, YB, P, args.out, HB, cntw, tok2, ti, gw, NGW, lane);
            } else if (PH_ON(5) && s == 4) {
                build_moe_tables(cntw, lds, tid);
                pg8::MoeOrder S; S.tb = (const LAS int*)(lds + TB_OFF); S.cnt = (const LAS int*)(lds + CNT_OFF);
                S.so.init(__builtin_amdgcn_readfirstlane(S.tb[32]), 4, G, bx);
                pg8::EpiSilu E{ACT};
                pg8::gemm_phase<pg8::EpiSilu, pg8::MoeOrder, true, true>(tid, lds + RING_OFF, HB, (const bf16*)(ws + WS_W1), D, (size_t)D * D, tok2, S, E);
            } else if (PH_ON(6) && s == 5) {
                build_moe_tables(cntw, lds, tid);
                pg8::MoeOrder S; S.tb = (const LAS int*)(lds + TB_OFF); S.cnt = (const LAS int*)(lds + CNT_OFF);
                S.so.init(__builtin_amdgcn_readfirstlane(S.tb[32]), 4, G, bx);
                pg8::EpiPlain E{YS, D};
                pg8::gemm_phase<pg8::EpiPlain, pg8::MoeOrder, false, true>(tid, lds + RING_OFF, ACT, (const bf16*)(ws + WS_W2), DEXP, (size_t)D * DEXP, nullptr, S, E);
            } else if (PH_ON(7)) {
                build_moe_tables(cntw, lds, tid);
                ln2_combine_phase(args.out, YS, P, HB, ti, lds, gw, NGW, lane);
                if (l + 1 < NLAYER) { const int k2 = (l + 1 == 1) ? 1 : (l + 1 == 2) ? 2 : 0; __syncthreads(); convert_layer_weights(args.L[l + 1], k2 == 0 ? 1536 : 3072, ws, lds, gw, NGW, wave, lane); }
            }
        }
        if (ph + 1 < hi) xcd_barrier(bar);
    }
}

#if MK_VERIFY
__global__ void __launch_bounds__(NWAVES * 64) mk_verify(Args args) {
    extern __shared__ __attribute__((aligned(16))) unsigned char lds_raw[];
    LAS unsigned char* lds = (LAS unsigned char*)lds_raw;
    const int ph = args.ph_lo;
    if (ph == 63) { if (blockIdx.x == 0 && threadIdx.x == 0) { const unsigned w = __hip_atomic_load((unsigned*)(args.ws + WS_CTL) + CW_CODE, RLX_AGENT); if (w) { unsigned mk = 0u; for (int q = 0; q < 8; ++q) if (__hip_atomic_load((unsigned*)(args.ws + WS_CTL) + 4 + q, RLX_AGENT) > 1000u) mk |= 1u << q; args.out[0] = (64 - (int)w == 5) ? exp2f((float)(8 + (int)(mk & 15u) + 10 * (int)(mk >> 4))) : exp2f((float)(64 - (int)w + 2)); } } return; }
    const int vp = ph - 64;
    if (vp > 0) { const int l_ = (vp - 1) / 7, s_ = (vp - 1) % 7; if (s_ >= 3) build_moe_tables((unsigned*)(args.ws + WS_CTL) + CW_CNT + l_ * 32 * 32, lds, (int)threadIdx.x); }
    verify_phase(args, vp, args.ws, lds, (int)threadIdx.x, (int)blockIdx.x);
}
#endif
extern "C" void kernel_launch(void* const* d_in, const int* in_sizes, int n_in, void* d_out, int out_size, void* d_ws, size_t ws_size, hipStream_t stream) {
    static int grid = 0;
    if (grid == 0) {
        if (n_in != 57 || in_sizes[0] != M * D || out_size != M * D || ws_size < WS_END + (MK_VERIFY ? 144 * MiB : 0)) { fprintf(stderr, "kernel_launch: unexpected shapes (n_in %d, in0 %d, out %d, ws %zu); nothing launched\n", n_in, n_in > 0 ? in_sizes[0] : -1, out_size, ws_size); grid = -1; return; }
        int dev = 0, cus = 0, per_cu = 0;
        if (hipGetDevice(&dev) != hipSuccess || hipDeviceGetAttribute(&cus, hipDeviceAttributeMultiprocessorCount, dev) != hipSuccess) { grid = -1; return; }
#if MK_VERIFY
        (void)hipFuncSetAttribute((const void*)mk_verify, hipFuncAttributeMaxDynamicSharedMemorySize, LDS_BYTES);
#endif
        if (hipFuncSetAttribute((const void*)mk_fwd, hipFuncAttributeMaxDynamicSharedMemorySize, LDS_BYTES) != hipSuccess) { fprintf(stderr, "kernel_launch: hipFuncSetAttribute failed\n"); grid = -1; return; }
        if (hipOccupancyMaxActiveBlocksPerMultiprocessor(&per_cu, (const void*)mk_fwd, NWAVES * 64, LDS_BYTES) != hipSuccess || per_cu < 1) { fprintf(stderr, "kernel_launch: occupancy query says %d blocks/CU\n", per_cu); }
        (void)hipGetLastError();
        grid = cus;
    }
    if (grid < 0) return;
    (void)hipMemsetAsync((char*)d_ws + WS_CTL, 0, CTL_ZERO_BYTES, stream);
    Args a{};
    a.x = (const float*)d_in[0]; a.t5 = (const float*)d_in[1];
    int k = 2;
    for (int l = 0; l < NLAYER; ++l) {
        const int kind = (l == 1) ? 1 : (l == 2) ? 2 : 0; LayerP& P = a.L[l];
        P.wqkv = (const float*)d_in[k++];
        P.extra = (kind == 1) ? nullptr : (const float*)d_in[k++];
        P.wo = (const float*)d_in[k++]; P.ln1g = (const float*)d_in[k++]; P.ln1b = (const float*)d_in[k++];
        P.rgw = (const float*)d_in[k++]; P.rgb = (const float*)d_in[k++]; P.rew = (const float*)d_in[k++]; P.reb = (const float*)d_in[k++];
        P.wg = (const float*)d_in[k++]; P.wu = (const float*)d_in[k++]; P.wd = (const float*)d_in[k++]; P.ln2g = (const float*)d_in[k++]; P.ln2b = (const float*)d_in[k++];
    }
    a.out = (float*)d_out; a.ws = (unsigned char*)d_ws;
#if MK_VERIFY
    for (int ph = 0; ph <= NPHASE; ++ph) {
        if (ph < NPHASE) {
            const int s_ = ph ? (ph - 1) % 7 : -1, l_ = ph ? (ph - 1) / 7 : 0;
            if ((s_ == 3 && l_ > 0) || s_ == 6) (void)hipMemcpyAsync((char*)d_ws + WS_SNAP, d_out, (size_t)M * D * 4, hipMemcpyDeviceToDevice, stream);
            a.ph_lo = ph; a.ph_hi = ph + 1; a.li = 0;
            hipLaunchKernelGGL(mk_fwd, dim3(grid), dim3(NWAVES * 64), LDS_BYTES, stream, a);
            a.ph_lo = 64 + ph; a.ph_hi = 65 + ph;
            hipLaunchKernelGGL(mk_verify, dim3(grid), dim3(NWAVES * 64), LDS_BYTES, stream, a);
        } else { a.ph_lo = 63; a.ph_hi = 64; hipLaunchKernelGGL(mk_verify, dim3(grid), dim3(NWAVES * 64), LDS_BYTES, stream, a); }
    }
#else
    constexpr int NL = MK_N_LAUNCHES;
    for (int li = 0; li < NL; ++li) {
        a.ph_lo = (NL == NPHASE) ? li : (li * NPHASE) / NL; a.ph_hi = (NL == NPHASE) ? li + 1 : ((li + 1) * NPHASE) / NL; a.li = li;
        hipLaunchKernelGGL(mk_fwd, dim3(grid), dim3(NWAVES * 64), LDS_BYTES, stream, a);
        const hipError_t le = hipPeekAtLastError();
        if (le != hipSuccess) { fprintf(stderr, "kernel_launch: launch %d failed: %s\n", li, hipGetErrorName(le)); break; }
    }
#endif
}
```

```cpp
#include <hip/hip_runtime.h>
#include <cstdio>
#include <cstdint>

#ifndef MK_N_LAUNCHES
#define MK_N_LAUNCHES 1
#endif

#ifndef MK_EARLY_ACQ
#define MK_EARLY_ACQ 1
#endif
#ifndef MK_COOPC
#define MK_COOPC 1
#endif
#ifndef MK_DRYA
#define MK_DRYA 0
#endif
#define LAS __attribute__((address_space(3)))
#define GAS __attribute__((address_space(1)))
typedef unsigned short bf16;
typedef unsigned v4u __attribute__((ext_vector_type(4)));
typedef unsigned v2u __attribute__((ext_vector_type(2)));
typedef float f32x4 __attribute__((ext_vector_type(4)));
typedef float f32x2 __attribute__((ext_vector_type(2)));
typedef short bf16x8 __attribute__((ext_vector_type(8)));

constexpr int BATCH = 8, SEQ = 4096, D = 1024, H = 16, HD = 64, M = BATCH * SEQ;
constexpr int NEXP = 32, DEXP = 512, NLAYER = 4;
constexpr float LN_EPS = 1e-5f;
constexpr float ALPHA = 1.681792830507429f;
constexpr int NWAVES = 8;
constexpr int NPHASE = 1 + 7 * NLAYER;

constexpr size_t MiB = 1u << 20;
constexpr size_t WS_CTL = 0, CTL_ZERO_BYTES = 160 * 1024;
constexpr size_t WS_BIAS = 1 * MiB;
constexpr size_t WS_WQKV = 2 * MiB, WS_WO = 8 * MiB, WS_W1 = 10 * MiB, WS_W2 = 74 * MiB;
constexpr size_t WSET2_OFF = 598 * MiB;
constexpr size_t WS_HB = 106 * MiB;
constexpr size_t WS_TOK2 = 170 * MiB;
constexpr size_t WS_TI = 174 * MiB;
constexpr size_t WS_Q = 176 * MiB, WS_K = 240 * MiB, WS_V = 304 * MiB, WS_AO = 368 * MiB;
constexpr size_t WS_Y = WS_Q;
constexpr size_t WS_ACT = 176 * MiB;
constexpr size_t WS_YS = 248 * MiB;
constexpr size_t WS_END = 432 * MiB;
constexpr int CW_TMO = 0, CW_CODE = 1, CW_BAR = 4096, CW_CNT = 16384;

constexpr int RING_OFF = 0, RING_BYTES = 131072;
constexpr int VO_OFF = RING_BYTES;
constexpr int LDSCTL_OFF = VO_OFF + 16384;
constexpr int MISC_OFF = LDSCTL_OFF + 320;
constexpr int TB_OFF = MISC_OFF + 128;
constexpr int CNT_OFF = TB_OFF + 160;
constexpr int TE_OFF = CNT_OFF + 128;
constexpr int TABB_OFF = LDSCTL_OFF + 2048;
constexpr int MRG_OFF = TABB_OFF + 2048;
constexpr int LDS_BYTES = 153600;
static_assert(TE_OFF + 1280 <= TABB_OFF && MRG_OFF + 2048 <= LDS_BYTES, "LDS map");

#define RLX_AGENT __ATOMIC_RELAXED, __HIP_MEMORY_SCOPE_AGENT
#define LDS_WAIT() asm volatile("s_waitcnt lgkmcnt(0)" ::: "memory")
#define VM_WAIT() asm volatile("s_waitcnt vmcnt(0)" ::: "memory")
__device__ __forceinline__ unsigned f2bf(float f) { unsigned u = __builtin_bit_cast(unsigned, f); return (u + 0x7fffu + ((u >> 16) & 1u)) >> 16; }
__device__ __forceinline__ unsigned pk2(float lo, float hi) { return f2bf(lo) | (f2bf(hi) << 16); }
__device__ __forceinline__ float bflo(unsigned w) { return __builtin_bit_cast(float, w << 16); }
__device__ __forceinline__ float bfhi(unsigned w) { return __builtin_bit_cast(float, w & 0xffff0000u); }
typedef _Float16 f16x8 __attribute__((ext_vector_type(8)));
typedef _Float16 f16x2 __attribute__((ext_vector_type(2)));
__device__ __forceinline__ unsigned pkh(float lo, float hi) { f16x2 h; h.x = (_Float16)lo; h.y = (_Float16)hi; return __builtin_bit_cast(unsigned, h); }
__device__ __forceinline__ float hlo(unsigned w) { const unsigned short s = (unsigned short)(w & 0xffffu); return (float)__builtin_bit_cast(_Float16, s); }
__device__ __forceinline__ float hhi(unsigned w) { const unsigned short s = (unsigned short)(w >> 16); return (float)__builtin_bit_cast(_Float16, s); }
#define DPP_ADD(v, ctrl) ((v) + __builtin_bit_cast(float, __builtin_amdgcn_update_dpp(0, __builtin_bit_cast(int, (v)), (ctrl), 0xF, 0xF, true)))
__device__ __forceinline__ float wave_sum(float v) {
    v = DPP_ADD(v, 0xB1); v = DPP_ADD(v, 0x4E); v = DPP_ADD(v, 0x141); v = DPP_ADD(v, 0x140);
    const int b = __builtin_bit_cast(int, v);
    const float r0 = __builtin_bit_cast(float, __builtin_amdgcn_readlane(b, 0)), r1 = __builtin_bit_cast(float, __builtin_amdgcn_readlane(b, 16));
    const float r2 = __builtin_bit_cast(float, __builtin_amdgcn_readlane(b, 32)), r3 = __builtin_bit_cast(float, __builtin_amdgcn_readlane(b, 48));
    return (r0 + r1) + (r2 + r3);
}
__device__ __forceinline__ float xor32_max(float v) { const auto rr = __builtin_amdgcn_permlane32_swap(__builtin_bit_cast(unsigned, v), __builtin_bit_cast(unsigned, v), false, false);
    const unsigned a0 = rr[0], a1 = rr[1]; return fmaxf(__builtin_bit_cast(float, a0), __builtin_bit_cast(float, a1)); }
__device__ __forceinline__ float xor32_sum(float v) { const auto rr = __builtin_amdgcn_permlane32_swap(__builtin_bit_cast(unsigned, v), __builtin_bit_cast(unsigned, v), false, false);
    const unsigned a0 = rr[0], a1 = rr[1]; return __builtin_bit_cast(float, a0) + __builtin_bit_cast(float, a1); }
__device__ __forceinline__ int t5_bucket(int rel) {
    const int n = rel < 0 ? -rel : rel;
    int b = n < 8 ? n : 8 + (n >= 15) + (n >= 27) + (n >= 50) + (n >= 91) + (n >= 166) + (n >= 305) + (n >= 559);
    return b + (rel > 0 ? 16 : 0);
}

namespace pg8 {
typedef unsigned short bf16_t;
typedef unsigned u32x4 __attribute__((ext_vector_type(4)));
constexpr int BM = 256, BK = 64, HALF = 128, HTB = HALF * BK * 2, STAGE_BYTES = 8 * HTB, NXCD = 8, WGM = 8;
__host__ __device__ __forceinline__ int lds_byte(int r, int c) { const int st = (r >> 4) * 2 + (c >> 5), rr = r & 15, cc = c & 31, ob = rr * 64 + cc * 2; return st * 1024 + (ob ^ (((ob >> 9) & 1) << 5)); }
__host__ __device__ __forceinline__ void stage_rc(int b, int& R, int& C) { const int st = b / 1024, sb = b % 1024, swz = sb ^ (((sb >> 9) & 1) << 5); R = (st >> 1) * 16 + swz / 64; C = (st & 1) * 32 + (swz % 64) / 2; }
__host__ __device__ __forceinline__ int perm32(int rho) { const int n = rho >> 4, i = rho & 15; return 8 * (i >> 2) + 4 * n + (i & 3); }

struct Unit { int pm, pn, e, r0, nv; };

struct StaticOrder {
    int nM, nN, nwg, G, c;
    __device__ __forceinline__ void init(int nM_, int nN_, int G_, int c_) { nM = nM_; nN = nN_; nwg = nM * nN; G = G_; c = c_; }
    __device__ __forceinline__ bool next(int i, Unit& u) const {
        const long L = (long)i * G + c; if (L >= nwg) return false;
        int wgid = (int)L; { const int q = nwg / NXCD, r = nwg % NXCD, xcd = wgid % NXCD, off = wgid / NXCD; wgid = (xcd < r ? xcd * (q + 1) : r * (q + 1) + (xcd - r) * q) + off; }
        const int nig = WGM * nN, gid = wgid / nig, fm = gid * WGM, gsz = (nM - fm) < WGM ? (nM - fm) : WGM, wi = wgid - gid * nig;
        if (gsz == WGM) { u.pm = fm + (wi & (WGM - 1)); u.pn = wi / WGM; }
        else { u.pm = fm + (wi % gsz); u.pn = wi / gsz; } u.e = 0; u.r0 = 0; u.nv = 256; return true;
    }
};
struct MoeOrder {
    StaticOrder so; const LAS int* tb; const LAS int* cnt; const LAS unsigned* te;
    __device__ __forceinline__ bool next(int i, Unit& u) const {
        if (!so.next(i, u)) return false;
        const unsigned w = (unsigned)__builtin_amdgcn_readfirstlane((int)te[u.pm]);
        u.e = (int)(w & 31u); u.r0 = (int)(w >> 20) * 256; u.nv = (int)((w >> 8) & 0xfffu); return true;
    }
};

__device__ __forceinline__ unsigned cvt_pk_bf16(float lo, float hi) { unsigned r; asm volatile("v_cvt_pk_bf16_f32 %0, %1, %2" : "=v"(r) : "v"(lo), "v"(hi)); return r; }

constexpr int M_TOK = 32768;
struct EpiQKV {
    static constexpr bool PERM = true;
    bf16_t *Q, *K, *V; int kvw; float qscale;
    __device__ __forceinline__ void operator()(const f32x4 (&acc)[2][2][4][2], const Unit& u, int wr, int wc, int fr, int fq) const {
        const int row0 = u.pm * BM + wr * 64 + fr; int colt = u.pn * BM; bf16_t* base; int ldc; float sc = 1.f;
        if (colt < 1024) { base = Q; ldc = 1024; sc = qscale; } else if (colt < 1024 + kvw) { base = K; ldc = kvw; colt -= 1024; } else { base = V; ldc = kvw; colt -= 1024 + kvw; }
        (void)ldc;
        const int col0 = colt + wc * 32 + 8 * fq;
#pragma unroll
        for (int ai = 0; ai < 2; ++ai)
#pragma unroll
            for (int m = 0; m < 4; ++m) { const size_t row = (size_t)(row0 + ai * HALF + m * 16);
#pragma unroll
                for (int bj = 0; bj < 2; ++bj) { const f32x4 v0 = acc[ai][bj][m][0] * sc, v1 = acc[ai][bj][m][1] * sc; const int c = col0 + bj * HALF;
                    u32x4 w; w.x = cvt_pk_bf16(v0[0], v0[1]); w.y = cvt_pk_bf16(v0[2], v0[3]); w.z = cvt_pk_bf16(v1[0], v1[1]); w.w = cvt_pk_bf16(v1[2], v1[3]);
                    *(u32x4*)(base + ((size_t)(c >> 6) * M_TOK + row) * 64 + (c & 63)) = w; } }
    }
};
struct EpiPlain {
    static constexpr bool PERM = true;
    bf16_t* O; int ldc;
    __device__ __forceinline__ void operator()(const f32x4 (&acc)[2][2][4][2], const Unit& u, int wr, int wc, int fr, int fq) const {
        const int row0 = u.pm * BM + wr * 64 + fr; const int col0 = u.pn * BM + wc * 32 + 8 * fq;
#pragma unroll
        for (int ai = 0; ai < 2; ++ai)
#pragma unroll
            for (int m = 0; m < 4; ++m) { bf16_t* rowp = O + (size_t)(row0 + ai * HALF + m * 16) * ldc + col0;
#pragma unroll
                for (int bj = 0; bj < 2; ++bj) { const f32x4 v0 = acc[ai][bj][m][0], v1 = acc[ai][bj][m][1];
                    u32x4 w; w.x = cvt_pk_bf16(v0[0], v0[1]); w.y = cvt_pk_bf16(v0[2], v0[3]); w.z = cvt_pk_bf16(v1[0], v1[1]); w.w = cvt_pk_bf16(v1[2], v1[3]);
                    *(u32x4*)(rowp + bj * HALF) = w; } }
    }
};
__device__ __forceinline__ float silu_mul(float g, float u) { return g * u * __builtin_amdgcn_rcpf(1.0f + __builtin_amdgcn_exp2f(-1.4426950408889634f * g)); }
struct EpiSilu {
    static constexpr bool PERM = true;
    bf16_t* O;
    __device__ __forceinline__ void operator()(const f32x4 (&acc)[2][2][4][2], const Unit& u, int wr, int wc, int fr, int fq) const {
        const int row0 = u.pm * BM + wr * 64 + fr; const int col0 = u.pn * HALF + wc * 32 + 8 * fq;
#pragma unroll
        for (int ai = 0; ai < 2; ++ai)
#pragma unroll
            for (int m = 0; m < 4; ++m) { bf16_t* rowp = O + (size_t)(row0 + ai * HALF + m * 16) * 512 + col0;
                const f32x4 g0 = acc[ai][0][m][0], g1 = acc[ai][0][m][1], u0 = acc[ai][1][m][0], u1 = acc[ai][1][m][1];
                u32x4 w; w.x = cvt_pk_bf16(silu_mul(g0[0], u0[0]), silu_mul(g0[1], u0[1])); w.y = cvt_pk_bf16(silu_mul(g0[2], u0[2]), silu_mul(g0[3], u0[3]));
                w.z = cvt_pk_bf16(silu_mul(g1[0], u1[0]), silu_mul(g1[1], u1[1])); w.w = cvt_pk_bf16(silu_mul(g1[2], u1[2]), silu_mul(g1[3], u1[3]));
                *(u32x4*)rowp = w; }
    }
};

template <class Epi, class Sched, bool GATHER, bool ALIGN_EPI, bool F16 = false>
__device__ __forceinline__ void gemm_phase(const int tid, LAS unsigned char* lds, const bf16_t* A, const bf16_t* Bt, const int K, const size_t estride, const int* toks, const Sched& S, const Epi& E) {
    const int wid = __builtin_amdgcn_readfirstlane(tid >> 6), lane = tid & 63, wr = wid >> 2, wc = wid & 3, fr = lane & 15, fq = lane >> 4;
    const int nt = K / BK;
    unsigned voffA[2], voffB[2];
#pragma unroll
    for (int i = 0; i < 2; ++i) { int R, C; stage_rc(tid * 16 + i * 8192, R, C); const int Rb = Epi::PERM ? ((R & ~31) + perm32(R & 31)) : R; voffA[i] = (unsigned)(R * K + C) * 2u; voffB[i] = (unsigned)(Rb * K + C) * 2u; }
    const size_t kstep = (size_t)(BK * 2);
    const size_t hstep = (size_t)HALF * K * 2;
    const size_t tstep = 2 * hstep;
    const unsigned ldsw = (unsigned)wid * 1024u;
    const int aoff = lds_byte(wr * 64 + fr, fq * 8), boff = lds_byte(wc * 32 + fr, fq * 8);
#define PG8_SA(b, h) (((b) * 2 + (h)) * HTB)
#define PG8_SB(b, h) ((4 + (b) * 2 + (h)) * HTB)
#define PG8_STAGE2(bufoff, gbase, v0, v1) do { \
        __builtin_amdgcn_global_load_lds((const unsigned*)((const char*)(gbase) + (v0)), (LAS unsigned*)(lds + (bufoff) + ldsw), 16, 0, 0); \
        __builtin_amdgcn_global_load_lds((const unsigned*)((const char*)(gbase) + (v1)), (LAS unsigned*)(lds + (bufoff) + ldsw + 8192), 16, 0, 0); } while (0)
#define PG8_STAGE_B(bufoff, gbase) PG8_STAGE2(bufoff, gbase, voffB[0], voffB[1])
#define PG8_STAGE_A(bufoff, gbase, set, h) do { if constexpr (GATHER) { const v2u vo_ = *(const LAS v2u*)(vol + (set) * 8192 + (h) * 8); PG8_STAGE2(bufoff, gbase, vo_.x, vo_.y); } else { PG8_STAGE2(bufoff, (gbase) + (h) * hstep, voffA[0], voffA[1]); } } while (0)
#define PG8_LDA(dst, b, h) do { _Pragma("unroll") for (int m = 0; m < 4; ++m) _Pragma("unroll") for (int k = 0; k < 2; ++k) dst[m][k] = *(const LAS bf16x8*)(lds + PG8_SA(b, h) + aoff + m * 2048 + k * 1024); } while (0)
#define PG8_LDB(dst, b, h) do { _Pragma("unroll") for (int n = 0; n < 2; ++n) _Pragma("unroll") for (int k = 0; k < 2; ++k) dst[n][k] = *(const LAS bf16x8*)(lds + PG8_SB(b, h) + boff + n * 2048 + k * 1024); } while (0)
#define PG8_MMA(ai, bj, At, Bt_) do { __builtin_amdgcn_s_setprio(1); _Pragma("unroll") for (int m = 0; m < 4; ++m) _Pragma("unroll") for (int n = 0; n < 2; ++n) _Pragma("unroll") for (int k = 0; k < 2; ++k) \
        { if constexpr (F16) acc[ai][bj][m][n] = __builtin_amdgcn_mfma_f32_16x16x32_f16(__builtin_bit_cast(f16x8, Bt_[n][k]), __builtin_bit_cast(f16x8, At[m][k]), acc[ai][bj][m][n], 0, 0, 0); \
          else acc[ai][bj][m][n] = __builtin_amdgcn_mfma_f32_16x16x32_bf16(Bt_[n][k], At[m][k], acc[ai][bj][m][n], 0, 0, 0); } __builtin_amdgcn_s_setprio(0); } while (0)
#define PG8_WAIT_V(n) asm volatile("s_waitcnt vmcnt(" #n ")" ::: "memory")
#define PG8_WAIT_L(n) asm volatile("s_waitcnt lgkmcnt(" #n ")" ::: "memory")
#define PG8_BAR __builtin_amdgcn_s_barrier()
#define PG8_SCHED __builtin_amdgcn_sched_barrier(0)
#define PG8_MKVO(u, set) do { if constexpr (GATHER) { int tk_[2][2]; const int* tp_ = toks + (size_t)(u).e * 32768 + (u).r0;        \
        _Pragma("unroll") for (int h_ = 0; h_ < 2; ++h_) _Pragma("unroll") for (int i_ = 0; i_ < 2; ++i_) { int R_, C_; stage_rc(tid * 16 + i_ * 8192, R_, C_); const int rl_ = h_ * HALF + R_; tk_[h_][i_] = tp_[rl_ < (u).nv ? rl_ : 0]; } \
        _Pragma("unroll") for (int h_ = 0; h_ < 2; ++h_) _Pragma("unroll") for (int i_ = 0; i_ < 2; ++i_) { int R_, C_; stage_rc(tid * 16 + i_ * 8192, R_, C_); const int rl_ = h_ * HALF + R_; const int tok_ = rl_ < (u).nv ? tk_[h_][i_] : 0; \
        *(LAS unsigned*)(vol + (set) * 8192 + h_ * 8 + i_ * 4) = (unsigned)tok_ * (unsigned)(K * 2) + (unsigned)(C_ * 2); } } } while (0)
#define PG8_BASEA(u) (GATHER ? (const char*)A : (const char*)A + (size_t)(u).pm * tstep)
#define PG8_BASEB(u) ((const char*)Bt + ((size_t)(u).e * estride) * 2 + (size_t)(u).pn * tstep)
    Unit cur, nxt; int ui = 0;
    if (!S.next(0, cur)) return;
    f32x4 acc[2][2][4][2];
#pragma unroll
    for (int a = 0; a < 2; ++a)
#pragma unroll
        for (int b = 0; b < 2; ++b)
#pragma unroll
            for (int m = 0; m < 4; ++m)
#pragma unroll
                for (int n = 0; n < 2; ++n) acc[a][b][m][n] = (f32x4){0.f, 0.f, 0.f, 0.f};
    bf16x8 At[4][2], B0[2][2], B1[2][2];
    LAS unsigned char* vol = lds + VO_OFF + tid * 16;
    int cs = 0;
    PG8_MKVO(cur, 0);
    const char* cA = PG8_BASEA(cur); const char* cB = PG8_BASEB(cur);
    PG8_STAGE_B(PG8_SB(0, 0), cB); PG8_STAGE_B(PG8_SB(0, 1), cB + hstep); PG8_STAGE_A(PG8_SA(0, 0), cA, 0, 0); PG8_STAGE_A(PG8_SA(0, 1), cA, 0, 1);
    if (wr == 1) PG8_BAR;
    PG8_WAIT_V(2); PG8_BAR;
    PG8_STAGE_B(PG8_SB(1, 0), cB + kstep); PG8_STAGE_A(PG8_SA(1, 0), cA + kstep, 0, 0); PG8_STAGE_B(PG8_SB(1, 1), cB + hstep + kstep);
    PG8_WAIT_V(6); PG8_BAR;
    for (;;) {
        const bool has_next = S.next(ui + 1, nxt);
        const char* nA = cA; const char* nB = cB;
        int ns = cs;
        if (has_next) { nA = PG8_BASEA(nxt); nB = PG8_BASEB(nxt); ns = cs ^ 1; PG8_MKVO(nxt, ns); }
        for (int t = 0; t < nt; t += 2) {
            const bool last = (t == nt - 2);
            const char* a1 = cA + (size_t)(t + 1) * kstep;
            const char* a2 = last ? nA : cA + (size_t)(t + 2) * kstep; const char* b2 = last ? nB : cB + (size_t)(t + 2) * kstep;
            const char* a3 = a2 + kstep; const char* b3 = b2 + kstep;
            const int ss = last ? ns : cs;
            PG8_LDB(B0, 0, 0); PG8_LDB(B1, 0, 1); PG8_SCHED; PG8_LDA(At, 0, 0); PG8_STAGE_A(PG8_SA(1, 1), a1, cs, 1);
            PG8_WAIT_V(8); PG8_WAIT_L(0); PG8_BAR; PG8_MMA(0, 0, At, B0); PG8_MMA(0, 1, At, B1); PG8_BAR; PG8_SCHED;
            PG8_LDA(At, 0, 1); PG8_STAGE_B(PG8_SB(0, 0), b2); PG8_STAGE_B(PG8_SB(0, 1), b2 + hstep); PG8_STAGE_A(PG8_SA(0, 0), a2, ss, 0);
            PG8_WAIT_V(8); PG8_WAIT_L(0); PG8_BAR; PG8_MMA(1, 0, At, B0); PG8_MMA(1, 1, At, B1); PG8_BAR; PG8_SCHED;
            PG8_LDB(B0, 1, 0); PG8_LDB(B1, 1, 1); PG8_SCHED; PG8_LDA(At, 1, 0); PG8_STAGE_A(PG8_SA(0, 1), a2, ss, 1);
            PG8_WAIT_V(8); PG8_WAIT_L(0); PG8_BAR; PG8_MMA(0, 0, At, B0); PG8_MMA(0, 1, At, B1); PG8_BAR; PG8_SCHED;
            PG8_LDA(At, 1, 1); PG8_STAGE_B(PG8_SB(1, 0), b3); PG8_STAGE_B(PG8_SB(1, 1), b3 + hstep); PG8_STAGE_A(PG8_SA(1, 0), a3, ss, 0);
            PG8_WAIT_V(8); PG8_WAIT_L(0); PG8_BAR; PG8_MMA(1, 0, At, B0); PG8_MMA(1, 1, At, B1); PG8_BAR; PG8_SCHED;
        }
        if constexpr (ALIGN_EPI) { if (wr == 0) PG8_BAR; }
        E(acc, cur, wr, wc, fr, fq);
        if (!has_next) break;
#pragma unroll
        for (int a = 0; a < 2; ++a)
#pragma unroll
            for (int b = 0; b < 2; ++b)
#pragma unroll
                for (int m = 0; m < 4; ++m)
#pragma unroll
                    for (int n = 0; n < 2; ++n) acc[a][b][m][n] = (f32x4){0.f, 0.f, 0.f, 0.f};
        cur = nxt; cA = nA; cB = nB; ++ui; cs = ns;
        if constexpr (ALIGN_EPI) { if (wr == 1) PG8_BAR; }
    }
    PG8_WAIT_V(0);
    if constexpr (!ALIGN_EPI) { if (wr == 0) PG8_BAR; }
    PG8_BAR;
#undef PG8_SA
#undef PG8_SB
#undef PG8_STAGE2
#undef PG8_STAGE_A
#undef PG8_STAGE_B
#undef PG8_LDA
#undef PG8_LDB
#undef PG8_MMA
#undef PG8_WAIT_V
#undef PG8_WAIT_L
#undef PG8_BAR
#undef PG8_SCHED
#undef PG8_MKVO
#undef PG8_BASEA
#undef PG8_BASEB
}
}

#define XB_TMO      128
#define XB_XCNT(j)  (256  + 64 * (j))
#define XB_XSUB(j)  (1280 + 64 * (j))
#define XB_XGEN(j)  (2304 + 64 * (j))
#define XB_TOP      3328
#define XB_TOPGEN   3392
#define XCD_BAR_WORDS 3456
#define XB_SPIN_CAP (1u << 18)
__device__ __forceinline__ unsigned xb_ld(unsigned* p)              { return __hip_atomic_load(p, __ATOMIC_RELAXED, __HIP_MEMORY_SCOPE_AGENT); }
__device__ __forceinline__ unsigned xb_add(unsigned* p, unsigned v) { return __hip_atomic_fetch_add(p, v, __ATOMIC_RELAXED, __HIP_MEMORY_SCOPE_AGENT); }
__device__ __forceinline__ unsigned xb_xcc_id() { return (unsigned)__builtin_amdgcn_s_getreg((3 << 11) | 20) & 0xFu; }
#define XB_SPIN(cond, bar) do { unsigned _sp = 0; while (cond) { __builtin_amdgcn_s_sleep(1); \
    if ((++_sp & 255u) == 0u) { if (xb_ld(&(bar)[XB_TMO])) break; if (_sp > XB_SPIN_CAP) { atomicAdd(&(bar)[XB_TMO], 1u); break; } } } } while (0)
struct XcdBarrier { unsigned* bar; unsigned x; volatile LAS unsigned* st; };
__device__ __forceinline__ XcdBarrier xcd_barrier_post(unsigned* bar, volatile LAS unsigned* st) {
    XcdBarrier b; b.bar = bar; b.x = xb_xcc_id(); b.st = st;
    if (threadIdx.x == 0) (void)xb_add(&bar[XB_XCNT(b.x)], 1u);
    return b;
}
__device__ __forceinline__ void xcd_barrier_complete(unsigned* bar, unsigned x, unsigned& nloc, unsigned& nx) {
    const unsigned G = gridDim.x * gridDim.y * gridDim.z;
    unsigned sum, cnt, mine, sp = 0u;
    for (;;) {
        sum = 0u; cnt = 0u; mine = 0u;
#pragma unroll
        for (unsigned j = 0; j < 16; ++j) { const unsigned c = xb_ld(&bar[XB_XCNT(j)]); sum += c; cnt += (c > 0u) ? 1u : 0u; mine = (j == x) ? c : mine; }
        if (sum == G) break;
        __builtin_amdgcn_s_sleep(1);
        if ((++sp & 255u) == 0u) { if (xb_ld(&bar[XB_TMO])) break; if (sp > XB_SPIN_CAP) { atomicAdd(&bar[XB_TMO], 1u); break; } }
    }
    nloc = mine > 0u ? mine : 1u; nx = cnt > 0u ? cnt : 1u;
}
__device__ __forceinline__ void xcd_barrier(const XcdBarrier& b) {
    asm volatile("s_waitcnt vmcnt(0)" ::: "memory");
    __syncthreads();
    if (threadIdx.x == 0) {
        unsigned* bar = b.bar;
        __builtin_amdgcn_s_waitcnt(0);
#if MK_EARLY_ACQ
        __builtin_amdgcn_fence(__ATOMIC_ACQUIRE, "agent");
#endif
        unsigned nloc = b.st[0], nx = b.st[1];
        if (nloc == 0u) { xcd_barrier_complete(bar, b.x, nloc, nx); b.st[0] = nloc; b.st[1] = nx; }
        const unsigned old = xb_add(&bar[XB_XSUB(b.x)], 1u);
        const unsigned gen = old / nloc;
        if (old + 1u == (gen + 1u) * nloc) {
            __builtin_amdgcn_fence(__ATOMIC_RELEASE, "agent");
            asm volatile("s_waitcnt vmcnt(0)" ::: "memory");
            const unsigned og = xb_add(&bar[XB_TOP], 1u);
            const unsigned tg = og / nx;
            if (og + 1u == (tg + 1u) * nx) {
#pragma unroll
                for (unsigned j = 0; j < 16; ++j) __hip_atomic_fetch_add(&bar[XB_XGEN(j)], 1u, __ATOMIC_RELAXED, __HIP_MEMORY_SCOPE_AGENT);
            } else XB_SPIN(xb_ld(&bar[XB_XGEN(b.x)]) == gen, bar);
#if !MK_EARLY_ACQ
            __builtin_amdgcn_fence(__ATOMIC_ACQUIRE, "agent");
#endif
            asm volatile("s_waitcnt vmcnt(0)" ::: "memory");
        } else {
            XB_SPIN(xb_ld(&bar[XB_XGEN(b.x)]) == gen, bar);
#if !MK_EARLY_ACQ
            __builtin_amdgcn_fence(__ATOMIC_ACQUIRE, "agent");
#endif
            asm volatile("s_waitcnt vmcnt(0)" ::: "memory");
        }
    }
    __syncthreads();
}

struct LayerP { const float *wqkv, *extra, *wo, *ln1g, *ln1b, *rgw, *rgb, *rew, *reb, *wg, *wu, *wd, *ln2g, *ln2b; };
struct Args { const float* x; const float* t5; LayerP L[NLAYER]; float* out; unsigned char* ws; int ph_lo, ph_hi, li, pad; };

template <bool F16>
__device__ __forceinline__ void transpose_item(const float* W, int K, int N, bf16* WT, int ilv, LAS float* scrf, int item, int lane) {
    LAS unsigned* scr = (LAS unsigned*)scrf;
    const int nblk = N / 64, kb = item / nblk, nb = item % nblk, k0 = 64 * kb, n0 = 64 * nb;
    const int rbase = ilv ? ((n0 >> 7) * 256 + (n0 & 127) + (ilv == 2 ? 128 : 0)) : n0;
    const int kq = lane >> 4, nc = lane & 15;
    f32x4 w0[8], w1[8];
#pragma unroll
    for (int i = 0; i < 8; ++i) { const float* p = W + (size_t)(k0 + 8 * i + 2 * kq) * N + n0 + 4 * nc; w0[i] = *(const f32x4*)p; w1[i] = *(const f32x4*)(p + N); }
#pragma unroll
    for (int i = 0; i < 8; ++i) { LAS unsigned* d = scr + (4 * nc) * 33 + 4 * i + kq;
        if constexpr (F16) { d[0] = pkh(w0[i].x, w1[i].x); d[33] = pkh(w0[i].y, w1[i].y); d[66] = pkh(w0[i].z, w1[i].z); d[99] = pkh(w0[i].w, w1[i].w); }
        else { d[0] = pk2(w0[i].x, w1[i].x); d[33] = pk2(w0[i].y, w1[i].y); d[66] = pk2(w0[i].z, w1[i].z); d[99] = pk2(w0[i].w, w1[i].w); } }
    LDS_WAIT(); asm volatile("" ::: "memory");
    const int c = lane & 7;
#pragma unroll
    for (int j = 0; j < 8; ++j) { const int n = (lane >> 3) + 8 * j; const LAS unsigned* sp = scr + n * 33 + 4 * c;
        v4u o; o.x = sp[0]; o.y = sp[1]; o.z = sp[2]; o.w = sp[3];
        *(v4u*)(WT + (size_t)(rbase + n) * K + k0 + 8 * c) = o; }
    LDS_WAIT(); asm volatile("" ::: "memory");
}
__device__ __forceinline__ int convert_nitems(int nqkv) { return (D / 64) * (nqkv / 64) + (D / 64) * (D / 64) + NEXP * (2 * (D / 64) * (DEXP / 64) + (DEXP / 64) * (D / 64)); }
__device__ __forceinline__ void convert_layer_weights(const LayerP& P, int nqkv, unsigned char* ws, LAS unsigned char* lds, int first, int step, int ibeg, int iend, int wave, int lane) {
    LAS float* scr = (LAS float*)(lds + RING_OFF + wave * 16384);
    bf16* Wqkv_t = (bf16*)(ws + WS_WQKV); bf16* Wo_t = (bf16*)(ws + WS_WO); bf16* W1_t = (bf16*)(ws + WS_W1); bf16* W2_t = (bf16*)(ws + WS_W2);
    const int I_QKV = (D / 64) * (nqkv / 64), I_O = (D / 64) * (D / 64), I_G = (D / 64) * (DEXP / 64), I_D = (DEXP / 64) * (D / 64);
    const int I_E = 2 * I_G + I_D;
    for (int it = ibeg + first; it < iend; it += step) {
        int r = it;
        if (r < I_QKV) { transpose_item<true>(P.wqkv, D, nqkv, Wqkv_t, 0, scr, r, lane); continue; } r -= I_QKV;
        if (r < I_O) { transpose_item<false>(P.wo, D, D, Wo_t, 0, scr, r, lane); continue; } r -= I_O;
        const int e = r / I_E; r -= e * I_E;
        if (r < I_G) { transpose_item<true>(P.wg + (size_t)e * D * DEXP, D, DEXP, W1_t + (size_t)e * D * D, 1, scr, r, lane); continue; } r -= I_G;
        if (r < I_G) { transpose_item<true>(P.wu + (size_t)e * D * DEXP, D, DEXP, W1_t + (size_t)e * D * D, 2, scr, r, lane); continue; } r -= I_G;
        transpose_item<false>(P.wd + (size_t)e * DEXP * D, DEXP, D, W2_t + (size_t)e * D * DEXP, 0, scr, r, lane);
    }
}

#define DOT8(s, qv, c, W4) do { s += qv[8 * (c) + 0] * bflo(W4[0]) + qv[8 * (c) + 1] * bfhi(W4[0]) + qv[8 * (c) + 2] * bflo(W4[1]) + qv[8 * (c) + 3] * bfhi(W4[1]) \
                                  + qv[8 * (c) + 4] * bflo(W4[2]) + qv[8 * (c) + 5] * bfhi(W4[2]) + qv[8 * (c) + 6] * bflo(W4[3]) + qv[8 * (c) + 7] * bfhi(W4[3]); } while (0)
#define AXPY8(ov, c, p, W4) do { ov[8 * (c) + 0] += p * bflo(W4[0]); ov[8 * (c) + 1] += p * bfhi(W4[0]); ov[8 * (c) + 2] += p * bflo(W4[1]); ov[8 * (c) + 3] += p * bfhi(W4[1]); \
                                 ov[8 * (c) + 4] += p * bflo(W4[2]); ov[8 * (c) + 5] += p * bfhi(W4[2]); ov[8 * (c) + 6] += p * bflo(W4[3]); ov[8 * (c) + 7] += p * bfhi(W4[3]); } while (0)
#define ATT_KEY(krow, vrow, biasv) do { \
        const v4u* kp_ = (const v4u*)(krow); float s_ = 0.f; \
        _Pragma("unroll") for (int c_ = 0; c_ < 8; ++c_) { const v4u w_ = kp_[c_]; DOT8(s_, q, c_, w_); } \
        s_ += (biasv); \
        if (s_ > m) { const float f_ = expf(m - s_); l *= f_; _Pragma("unroll") for (int d_ = 0; d_ < 64; ++d_) o[d_] *= f_; m = s_; } \
        const float p_ = expf(s_ - m); l += p_; \
        const v4u* vp_ = (const v4u*)(vrow); \
        _Pragma("unroll") for (int c_ = 0; c_ < 8; ++c_) { const v4u w_ = vp_[c_]; AXPY8(o, c_, p_, w_); } } while (0)
#define ATT_LOADQ(qrow) do { const v4u* qp_ = (const v4u*)(qrow); _Pragma("unroll") for (int c_ = 0; c_ < 8; ++c_) { const v4u w_ = qp_[c_]; \
        q[8 * c_ + 0] = bflo(w_.x); q[8 * c_ + 1] = bfhi(w_.x); q[8 * c_ + 2] = bflo(w_.y); q[8 * c_ + 3] = bfhi(w_.y); q[8 * c_ + 4] = bflo(w_.z); q[8 * c_ + 5] = bfhi(w_.z); q[8 * c_ + 6] = bflo(w_.w); q[8 * c_ + 7] = bfhi(w_.w); } \
        _Pragma("unroll") for (int d_ = 0; d_ < 64; ++d_) o[d_] = 0.f; } while (0)
#define ATT_STOREO(orow) do { const float rl_ = 1.0f / l; v4u* op_ = (v4u*)(orow); _Pragma("unroll") for (int c_ = 0; c_ < 8; ++c_) { v4u w_; \
        w_.x = pk2(o[8 * c_ + 0] * rl_, o[8 * c_ + 1] * rl_); w_.y = pk2(o[8 * c_ + 2] * rl_, o[8 * c_ + 3] * rl_); w_.z = pk2(o[8 * c_ + 4] * rl_, o[8 * c_ + 5] * rl_); w_.w = pk2(o[8 * c_ + 6] * rl_, o[8 * c_ + 7] * rl_); op_[c_] = w_; } } while (0)

__device__ __forceinline__ void attnA_naive(const bf16* Q, const bf16* Kb, const bf16* Vb, const float* sink, const float* biasT, bf16* AO, int gw, int NGW, int lane) {
    for (int wi = gw; wi < (M / 64) * H; wi += NGW) {
        const int h = wi & 15, t = (wi >> 4) * 64 + lane, b = t >> 12, pos = t & 4095, kvh = h >> 2;
        float q[64], o[64]; ATT_LOADQ(Q + (size_t)t * D + h * HD);
        float m = sink[h], l = 1.0f;
        const float* bh = biasT + h * 2049 + 1024;
        const int j0 = pos - 128 < 0 ? 0 : pos - 128, j1 = pos + 128 > SEQ - 1 ? SEQ - 1 : pos + 128;
        for (int j = j0; j <= j1; ++j) { const size_t kr = ((size_t)(b * SEQ + j)) * 256 + kvh * HD; ATT_KEY(Kb + kr, Vb + kr, bh[j - pos]); }
        ATT_STOREO(AO + (size_t)t * D + h * HD);
    }
}
__device__ __forceinline__ void attnB_naive(const bf16* Q, const bf16* Kb, const bf16* Vb, const float* biasT, bf16* AO, int gw, int NGW, int lane) {
    for (int wi = gw; wi < (M / 64) * H; wi += NGW) {
        const int h = wi & 15, t = (wi >> 4) * 64 + lane, b = t >> 12, pos = t & 4095;
        float q[64], o[64]; ATT_LOADQ(Q + (size_t)t * D + h * HD);
        float m = -1e30f, l = 0.0f;
        const float* bh = biasT + h * 2049 + 1024;
#pragma unroll 1
        for (int br = 0; br < 3; ++br) { const int dil = br == 0 ? 1 : br == 1 ? 4 : 16;
            for (int mm = -64; mm <= 64; ++mm) { const int j = pos + dil * mm; if (j < 0 || j >= SEQ) continue;
                const size_t kr = ((size_t)(b * SEQ + j)) * D + h * HD; ATT_KEY(Kb + kr, Vb + kr, bh[dil * mm]); } }
        ATT_STOREO(AO + (size_t)t * D + h * HD);
    }
}
__device__ __forceinline__ void attnC_naive(const bf16* Q, const bf16* Kb, const bf16* Vb, const float* rpb, bf16* AO, int gw, int NGW, int lane) {
    for (int wi = gw; wi < (M / 64) * H; wi += NGW) {
        const int h = wi & 15, t = (wi >> 4) * 64 + lane, b = t >> 12, pos = t & 4095, r = pos >> 6, c = pos & 63;
        float q[64], o[64]; ATT_LOADQ(Q + (size_t)t * D + h * HD);
        float m = -1e30f, l = 0.0f;
        const int rs = r - 4 < 0 ? 0 : (r - 4 > 56 ? 56 : r - 4), cs = c - 8 < 0 ? 0 : (c - 8 > 48 ? 48 : c - 8);
        const float* bh = rpb + h * (15 * 31);
#pragma unroll 1
        for (int rr = rs; rr < rs + 8; ++rr)
            for (int cc = cs; cc < cs + 16; ++cc) { int dc = cc - c; dc = dc < -15 ? -15 : (dc > 15 ? 15 : dc);
                const size_t kr = ((size_t)(b * SEQ + rr * 64 + cc)) * D + h * HD; ATT_KEY(Kb + kr, Vb + kr, bh[(rr - r + 7) * 31 + dc + 15]); }
        ATT_STOREO(AO + (size_t)t * D + h * HD);
    }
}


typedef float f32x16 __attribute__((ext_vector_type(16)));
typedef short v4i16 __attribute__((ext_vector_type(4)));
constexpr float LOG2E = 1.4426950408889634f;
constexpr int VT_ROWB = 192;
constexpr int AW_BYTES = 32 * VT_ROWB;
constexpr int AT_OFF = NWAVES * AW_BYTES, AT_STRIDE = 512;
constexpr size_t WS_OB = 432 * MiB;
constexpr size_t WS_LSE = 560 * MiB;
constexpr size_t WS_END2 = 564 * MiB;
__device__ __forceinline__ int crow(int i, int hi) { return (i & 3) + 8 * (i >> 2) + 4 * hi; }
__device__ __forceinline__ int iclamp(int x, int lo, int hi) { return x < lo ? lo : (x > hi ? hi : x); }

constexpr float ATT_THR = 8.0f;
__device__ __forceinline__ f32x16 att_qk(const bf16x8 (&Kf)[4], const bf16x8 (&Qf)[4]) {
    f32x16 S;
#pragma unroll
    for (int i = 0; i < 16; ++i) S[i] = 0.f;
#pragma unroll
    for (int st = 0; st < 4; ++st) S = __builtin_amdgcn_mfma_f32_32x32x16_bf16(Kf[st], Qf[st], S, 0, 0, 0);
    return S;
}
__device__ __forceinline__ void att_vread(v4i16 (&Vt)[8], LAS unsigned char* vt, const int lane) {
    const int i16 = lane & 15, g = lane >> 4;
    const LAS unsigned char* vb = vt + (4 * (g >> 1) + (i16 >> 2)) * VT_ROWB + (16 * (g & 1) + 4 * (i16 & 3)) * 2;
#pragma unroll
    for (int s2 = 0; s2 < 2; ++s2)
#pragma unroll
        for (int db = 0; db < 2; ++db) {
            Vt[(s2 * 2 + db) * 2 + 0] = __builtin_amdgcn_ds_read_tr16_b64_v4i16((LAS v4i16*)(vb + (16 * s2) * VT_ROWB + db * 64));
            Vt[(s2 * 2 + db) * 2 + 1] = __builtin_amdgcn_ds_read_tr16_b64_v4i16((LAS v4i16*)(vb + (16 * s2 + 8) * VT_ROWB + db * 64));
        }
}
__device__ __forceinline__ void att_soft_pv(f32x16& O0, f32x16& O1, float& m, float& l, const f32x16& S, const v4i16 (&Vt)[8], const float (&bs)[16], const int lane) {
    float a[16];
#pragma unroll
    for (int i = 0; i < 16; ++i) a[i] = fmaf(S[i], LOG2E, bs[i] - m);
    float mx = fmaxf(fmaxf(fmaxf(a[0], a[1]), fmaxf(a[2], a[3])), fmaxf(fmaxf(a[4], a[5]), fmaxf(a[6], a[7])));
    mx = fmaxf(mx, fmaxf(fmaxf(fmaxf(a[8], a[9]), fmaxf(a[10], a[11])), fmaxf(fmaxf(a[12], a[13]), fmaxf(a[14], a[15]))));
    mx = xor32_max(mx);
    if (__builtin_amdgcn_ballot_w64(mx > ATT_THR) != 0ull) {
        const float dl = mx > ATT_THR ? mx : 0.f, al = __builtin_amdgcn_exp2f(-dl);
        m += dl; l *= al;
#pragma unroll
        for (int i = 0; i < 16; ++i) { a[i] -= dl; O0[i] *= al; O1[i] *= al; }
    }
#pragma unroll
    for (int i = 0; i < 16; ++i) a[i] = __builtin_amdgcn_exp2f(a[i]);
    l += ((a[0] + a[1]) + (a[2] + a[3])) + ((a[4] + a[5]) + (a[6] + a[7])) + (((a[8] + a[9]) + (a[10] + a[11])) + ((a[12] + a[13]) + (a[14] + a[15])));
    bf16x8 Pf[2];
#pragma unroll
    for (int s2 = 0; s2 < 2; ++s2) { v4u w; w.x = pg8::cvt_pk_bf16(a[8 * s2 + 0], a[8 * s2 + 1]); w.y = pg8::cvt_pk_bf16(a[8 * s2 + 2], a[8 * s2 + 3]);
        w.z = pg8::cvt_pk_bf16(a[8 * s2 + 4], a[8 * s2 + 5]); w.w = pg8::cvt_pk_bf16(a[8 * s2 + 6], a[8 * s2 + 7]); Pf[s2] = __builtin_bit_cast(bf16x8, w); }
#pragma unroll
    for (int s2 = 0; s2 < 2; ++s2)
#pragma unroll
        for (int db = 0; db < 2; ++db) {
            const v4i16 lo = Vt[(s2 * 2 + db) * 2 + 0], hi4 = Vt[(s2 * 2 + db) * 2 + 1];
            const bf16x8 Vf = {lo[0], lo[1], lo[2], lo[3], hi4[0], hi4[1], hi4[2], hi4[3]};
            if (db == 0) O0 = __builtin_amdgcn_mfma_f32_32x32x16_bf16(Vf, Pf[s2], O0, 0, 0, 0);
            else O1 = __builtin_amdgcn_mfma_f32_32x32x16_bf16(Vf, Pf[s2], O1, 0, 0, 0);
        }
}

struct AttItem { int b, h, kh, q0, dil, res, L, R, c0, cb, rs0, tlo, thi; };
template <int KIND, int MODE, bool NOLOAD = false>
__device__ __forceinline__ void attn_item(const AttItem it, const bf16* Qb, const bf16* Kb, const bf16* Vb, const int kvld, const float* biasT, const float* extra,
                                          bf16* AO, bf16* OB, float* LSE, const int br, LAS unsigned char* wl, LAS float* tabs, const int lane) {
    const int r = lane & 31, hi = lane >> 5;
    LAS unsigned char* vt = wl; LAS float* tab = tabs + it.h * AT_STRIDE;
    int qpos;
    if constexpr (KIND == 0) qpos = it.q0 + r; else if constexpr (KIND == 1) qpos = it.res + it.dil * (it.q0 + r); else qpos = (it.R + (r >> 4)) * 64 + it.c0 + (r & 15);
    const size_t tq = (size_t)it.b * SEQ + qpos;
    bf16x8 Qf[4];
#pragma unroll
    for (int st = 0; st < 4; ++st) Qf[st] = *(const bf16x8*)(Qb + tq * D + it.h * HD + 16 * st + 8 * hi);
    float m = 0.f, l = 0.f;
    if constexpr (KIND == 0) { m = extra[it.h] * LOG2E; l = hi == 0 ? 1.0f : 0.0f; }
    f32x16 O0, O1;
#pragma unroll
    for (int i = 0; i < 16; ++i) { O0[i] = 0.f; O1[i] = 0.f; }
    const int step = KIND == 1 ? it.dil : 1;
    const long pos0 = KIND == 0 ? (long)it.b * SEQ + it.q0 - 128 : KIND == 1 ? (long)it.b * SEQ + it.res + (long)it.dil * (it.q0 - 64) : (long)it.b * SEQ + it.rs0 * 64 + it.cb;
    const long tinc = KIND == 0 ? 32 : KIND == 1 ? 32 * it.dil : 64;
    const unsigned rowB = (unsigned)kvld * 2u;
    const unsigned kOff = (unsigned)(r * step) * rowB + 16u * hi;
    unsigned vOff[4];
#pragma unroll
    for (int j = 0; j < 4; ++j) vOff[j] = (unsigned)(((lane >> 3) + 8 * j) * step) * rowB + (lane & 7) * 16u;
    const char* kbase = (const char*)Kb + (pos0 + it.tlo * tinc) * (long)rowB + it.kh * (HD * 2);
    const char* vbase = (const char*)Vb + (pos0 + it.tlo * tinc) * (long)rowB + it.kh * (HD * 2);
    const long tstepB = tinc * (long)rowB;
    int tb0, tbinc; float cneg[16];
    if constexpr (KIND == 2) {
        const int cq = it.c0 + (r & 15), csq = iclamp(cq - 8, 0, 48), w0 = csq - it.cb;
#pragma unroll
        for (int i = 0; i < 16; ++i) cneg[i] = ((unsigned)(crow(i, hi) - w0) < 16u) ? 0.f : -1e30f;
        tb0 = 4 * (16 + (it.cb - cq + 15) + 4 * hi); tbinc = 0;
    } else { tb0 = 4 * (32 + 4 * hi - r); tbinc = 128;
#pragma unroll
        for (int i = 0; i < 16; ++i) cneg[i] = 0.f; }
    bf16x8 Kfa[4], Kfb[4]; v4u Vn[4];
#define ATT_LOADK(K_, kb_) do { _Pragma("unroll") for (int st = 0; st < 4; ++st) K_[st] = *(const bf16x8*)((kb_) + kOff + 32 * st); } while (0)
#define ATT_LOADV(vb_) do { _Pragma("unroll") for (int j = 0; j < 4; ++j) Vn[j] = *(const v4u*)((vb_) + vOff[j]); } while (0)
    ATT_LOADK(Kfa, kbase); ATT_LOADV(vbase);
    if (it.tlo + 1 < it.thi) ATT_LOADK(Kfb, kbase + tstepB);
    f32x16 Sc = att_qk(Kfa, Qf);
#define ATT_STEP(t_, KU_, KL_) do { const int tt_ = (t_); \
        _Pragma("unroll") for (int j = 0; j < 4; ++j) *(LAS v4u*)(vt + ((lane >> 3) + 8 * j) * VT_ROWB + (lane & 7) * 16) = Vn[j]; \
        v4i16 Vt[8]; att_vread(Vt, vt, lane); __builtin_amdgcn_sched_barrier(0); \
        kbase += tstepB; vbase += tstepB; \
        if constexpr (!NOLOAD) { if (tt_ + 1 < it.thi) ATT_LOADV(vbase); if (tt_ + 2 < it.thi) ATT_LOADK(KL_, kbase + tstepB); } \
        f32x16 Sn = Sc; \
        if (tt_ + 1 < it.thi) Sn = att_qk(KU_, Qf);                      \
        float bs[16]; \
        if constexpr (KIND == 2) { \
            const int rq = it.R + (r >> 4), kr2 = it.rs0 + tt_, rsq = iclamp(rq - 4, 0, 56); \
            const float rneg = (kr2 >= rsq && kr2 < rsq + 8) ? 0.f : -1e30f; \
            const LAS float* tp = (const LAS float*)((const LAS unsigned char*)tab + tb0 + 4 * 31 * iclamp(kr2 - rq + 7, 0, 14)); \
            _Pragma("unroll") for (int i = 0; i < 16; ++i) bs[i] = tp[(i & 3) + 8 * (i >> 2)] + (cneg[i] + rneg); \
        } else { \
            const LAS float* tp = (const LAS float*)((const LAS unsigned char*)tab + tb0 + tt_ * tbinc); \
            _Pragma("unroll") for (int i = 0; i < 16; ++i) bs[i] = tp[(i & 3) + 8 * (i >> 2)]; \
        } \
        att_soft_pv(O0, O1, m, l, Sc, Vt, bs, lane); \
        Sc = Sn; } while (0)
    for (int t = it.tlo; t < it.thi; t += 2) { ATT_STEP(t, Kfb, Kfa); if (t + 1 < it.thi) ATT_STEP(t + 1, Kfa, Kfb); }
#undef ATT_STEP
#undef ATT_LOADK
#undef ATT_LOADV
    const float lt = xor32_sum(l);
    const float inv = 1.0f / lt;
    if constexpr (MODE == 2) {
        const float lse3 = m + __builtin_amdgcn_logf(lt);
        const float lse1 = LSE[tq * 16 + it.h], lse2 = LSE[(size_t)M * 16 + tq * 16 + it.h];
        const float mm = fmaxf(lse3, fmaxf(lse1, lse2)), w1 = __builtin_amdgcn_exp2f(lse1 - mm), w2 = __builtin_amdgcn_exp2f(lse2 - mm), w3 = __builtin_amdgcn_exp2f(lse3 - mm), wi = 1.0f / (w1 + w2 + w3);
        const float c1 = w1 * wi, c2 = w2 * wi, c3 = w3 * wi * inv;
#pragma unroll
        for (int db = 0; db < 2; ++db)
#pragma unroll
            for (int g4 = 0; g4 < 4; ++g4) { const size_t off = tq * D + it.h * HD + 32 * db + 8 * g4 + 4 * hi;
                const v2u a1 = *(const v2u*)(OB + off), a2 = *(const v2u*)(OB + (size_t)M * D + off);
                const f32x16& O = db == 0 ? O0 : O1;
                const float x0 = c3 * O[4 * g4 + 0] + c1 * bflo(a1.x) + c2 * bflo(a2.x), x1 = c3 * O[4 * g4 + 1] + c1 * bfhi(a1.x) + c2 * bfhi(a2.x);
                const float x2 = c3 * O[4 * g4 + 2] + c1 * bflo(a1.y) + c2 * bflo(a2.y), x3 = c3 * O[4 * g4 + 3] + c1 * bfhi(a1.y) + c2 * bfhi(a2.y);
                v2u w; w.x = pg8::cvt_pk_bf16(x0, x1); w.y = pg8::cvt_pk_bf16(x2, x3); *(v2u*)(AO + off) = w; }
    } else {
        bf16* dst = MODE == 1 ? OB + (size_t)br * M * D : AO;
#pragma unroll
        for (int db = 0; db < 2; ++db)
#pragma unroll
            for (int g4 = 0; g4 < 4; ++g4) { const size_t off = tq * D + it.h * HD + 32 * db + 8 * g4 + 4 * hi; const f32x16& O = db == 0 ? O0 : O1;
                v2u w; w.x = pg8::cvt_pk_bf16(O[4 * g4 + 0] * inv, O[4 * g4 + 1] * inv); w.y = pg8::cvt_pk_bf16(O[4 * g4 + 2] * inv, O[4 * g4 + 3] * inv); *(v2u*)(dst + off) = w; }
        if constexpr (MODE == 1) { if (hi == 0) LSE[(size_t)br * M * 16 + tq * 16 + it.h] = m + __builtin_amdgcn_logf(lt); }
    }
}
constexpr int CO_V = 65536;
template <int MODE>
__device__ __forceinline__ void att_epilogue(const f32x16& O0, const f32x16& O1, const float m, const float l, const size_t tq, const int h, const int hi, bf16* AO, bf16* OB, float* LSE, const int br) {
    const float lt = xor32_sum(l);
    const float inv = 1.0f / lt;
    if constexpr (MODE == 2) {
        const float lse3 = m + __builtin_amdgcn_logf(lt);
        const float lse1 = LSE[tq * 16 + h], lse2 = LSE[(size_t)M * 16 + tq * 16 + h];
        const float mm = fmaxf(lse3, fmaxf(lse1, lse2)), w1 = __builtin_amdgcn_exp2f(lse1 - mm), w2 = __builtin_amdgcn_exp2f(lse2 - mm), w3 = __builtin_amdgcn_exp2f(lse3 - mm), wi = 1.0f / (w1 + w2 + w3);
        const float c1 = w1 * wi, c2 = w2 * wi, c3 = w3 * wi * inv;
#pragma unroll
        for (int db = 0; db < 2; ++db)
#pragma unroll
            for (int g4 = 0; g4 < 4; ++g4) { const size_t off = tq * D + h * HD + 32 * db + 8 * g4 + 4 * hi;
                const v2u a1 = *(const v2u*)(OB + off), a2 = *(const v2u*)(OB + (size_t)M * D + off);
                const f32x16& O = db == 0 ? O0 : O1;
                const float x0 = c3 * O[4 * g4 + 0] + c1 * bflo(a1.x) + c2 * bflo(a2.x), x1 = c3 * O[4 * g4 + 1] + c1 * bfhi(a1.x) + c2 * bfhi(a2.x);
                const float x2 = c3 * O[4 * g4 + 2] + c1 * bflo(a1.y) + c2 * bflo(a2.y), x3 = c3 * O[4 * g4 + 3] + c1 * bfhi(a1.y) + c2 * bfhi(a2.y);
                v2u w; w.x = pg8::cvt_pk_bf16(x0, x1); w.y = pg8::cvt_pk_bf16(x2, x3); *(v2u*)(AO + off) = w; }
    } else {
        bf16* dst = MODE == 1 ? OB + (size_t)br * M * D : AO;
#pragma unroll
        for (int db = 0; db < 2; ++db)
#pragma unroll
            for (int g4 = 0; g4 < 4; ++g4) { const size_t off = (MODE == 1 ? ((size_t)h * M + tq) * HD : tq * D + h * HD) + 32 * db + 8 * g4 + 4 * hi; const f32x16& O = db == 0 ? O0 : O1;
                v2u w; w.x = pg8::cvt_pk_bf16(O[4 * g4 + 0] * inv, O[4 * g4 + 1] * inv); w.y = pg8::cvt_pk_bf16(O[4 * g4 + 2] * inv, O[4 * g4 + 3] * inv); *(v2u*)(dst + off) = w; }
        if constexpr (MODE == 1) { if (hi == 0) LSE[(size_t)br * M * 16 + tq * 16 + h] = m + __builtin_amdgcn_logf(lt); }
    }
}
template <int KIND, int MODE>
__device__ __forceinline__ void attn_coop_phase(const bf16* Qb, const bf16* Kb, const bf16* Vb, const float* biasT, const float* extra, bf16* AO, bf16* OB, float* LSE,
                                                const int br, const int dil, LAS unsigned char* lds, const int tid, const int bx, const int G, const int wave, const int lane, const int nol = 0) {
    constexpr int W = KIND == 0 ? 128 : 64, NT = KIND == 0 ? 9 : 5, NH = KIND == 0 ? 4 : 1;
    const size_t rowB = (size_t)HD * 2;
    const int L = SEQ / dil, gpr = L / 256, lgp = dil == 16 ? 0 : (dil == 4 ? 2 : 4), nitems = KIND == 0 ? BATCH * 4 * 16 : BATCH * 16 * 16;
    const int tbid = KIND == 0 ? 0 : (dil == 16 ? 1 : (dil == 4 ? 2 : 3));
    const float* gtab = biasT + 65536 + tbid * 16 * AT_STRIDE;
    LAS unsigned char* Kl = lds + RING_OFF; LAS unsigned char* Vl = lds + RING_OFF + CO_V; LAS float* tabl = (LAS float*)(lds + VO_OFF);
    const int r = lane & 31, hi = lane >> 5, i16 = lane & 15, g4l = lane >> 4;
    int kfo[4];
#pragma unroll
    for (int st = 0; st < 4; ++st) kfo[st] = r * 128 + (((2 * st + hi) ^ (r & 7)) * 16);
    const int vrow = 4 * (g4l >> 1) + (i16 >> 2), vch = 2 * (g4l & 1) + ((i16 & 3) >> 1), vsw = 4 * ((i16 >> 3) & 1), vwi = 8 * (i16 & 1);
    const int vo0 = vrow * 128 + (vch + vsw) * 16 + vwi, vo1 = vrow * 128 + (vch + (4 - vsw)) * 16 + vwi;
    const int tb0 = 4 * (32 + 4 * hi - r);
#define CO_COORDS(item_, b_, kh_, h0_, res_, g_) do { if constexpr (KIND == 0) { g_ = (item_) & 15; kh_ = ((item_) >> 4) & 3; b_ = (item_) >> 6; res_ = 0; h0_ = kh_ * 4; } \
        else { const int idx_ = (item_) & 15; h0_ = ((item_) >> 4) & 15; b_ = (item_) >> 8; res_ = idx_ >> lgp; g_ = idx_ & (gpr - 1); kh_ = h0_; } } while (0)
#define CO_LOADQ(Q_, tq_, h_) do { _Pragma("unroll") for (int st = 0; st < 4; ++st) Q_[st] = *(const bf16x8*)(Qb + ((size_t)(h_) * M + (tq_)) * HD + 16 * st + 8 * hi); } while (0)
    const bool tab_once = (G % (KIND == 0 ? 64 : 256)) == 0;
    bf16x8 Qn[4];
    __syncthreads();
    if (bx < nitems) { int b, kh, h0, res, g; CO_COORDS(bx, b, kh, h0, res, g); (void)kh;
        CO_LOADQ(Qn, (size_t)b * SEQ + res + (size_t)dil * (g * 256 + 32 * wave + r), h0);
        if (tab_once) {
#pragma unroll
            for (int k = 0; k < (NH * 2 + NWAVES - 1) / NWAVES; ++k) { const int c1 = wave + NWAVES * k;
                if (c1 < NH * 2) __builtin_amdgcn_global_load_lds((const unsigned*)(gtab + (size_t)h0 * AT_STRIDE + c1 * 256 + lane * 4), (LAS unsigned*)((LAS unsigned char*)tabl + c1 * 1024), 16, 0, 0); } } }
    for (int item = bx; item < nitems; item += G) {
        int b, kh, h0, res, g; CO_COORDS(item, b, kh, h0, res, g);
        float sk[NH];
#pragma unroll
        for (int hs = 0; hs < NH; ++hs) sk[hs] = KIND == 0 ? extra[h0 + hs] : 0.f;
        const int i0g = g * 256, lo = i0g - W < 0 ? 0 : i0g - W, hie = i0g + 256 + W > L ? L : i0g + 256 + W, nrows = hie - lo;
        __syncthreads();
        { const char* kg = (const char*)Kb + ((size_t)kh * M + (size_t)b * SEQ + res) * rowB; const char* vg = (const char*)Vb + ((size_t)kh * M + (size_t)b * SEQ + res) * rowB;
          const int rin = lane >> 3, p = lane & 7;
#pragma unroll
          for (int j = 0; j < (KIND == 0 ? 8 : 6); ++j) { const int rg = wave + NWAVES * j, row = rg * 8 + rin;
              if (rg * 8 < nrows && !nol) { const size_t off = (size_t)(lo + row) * dil * rowB;
                  __builtin_amdgcn_global_load_lds((const unsigned*)(kg + off + ((p ^ (row & 7)) * 16)), (LAS unsigned*)(Kl + rg * 1024), 16, 0, 0);
                  __builtin_amdgcn_global_load_lds((const unsigned*)(vg + off + ((p ^ (4 * ((row >> 1) & 1))) * 16)), (LAS unsigned*)(Vl + rg * 1024), 16, 0, 0); } }
          if (!tab_once) {
#pragma unroll
              for (int k = 0; k < (NH * 2 + NWAVES - 1) / NWAVES; ++k) { const int c1 = wave + NWAVES * k;
                  if (c1 < NH * 2) __builtin_amdgcn_global_load_lds((const unsigned*)(gtab + (size_t)h0 * AT_STRIDE + c1 * 256 + lane * 4), (LAS unsigned*)((LAS unsigned char*)tabl + c1 * 1024), 16, 0, 0); } }
          __builtin_amdgcn_s_waitcnt(0x0F70); }
        __syncthreads();
        const int i0 = i0g + 32 * wave;
        const int tlo = i0 < W ? (W - i0) / 32 : 0, th_ = (L + W - i0) / 32, thi = th_ < NT ? th_ : NT;
        const size_t tq = (size_t)b * SEQ + res + (size_t)dil * (i0 + r);
#pragma unroll 1
        for (int hs = 0; hs < NH; ++hs) {
            const int h = h0 + hs;
            bf16x8 Qf[4];
#pragma unroll
            for (int st = 0; st < 4; ++st) Qf[st] = Qn[st];
            if (hs + 1 < NH) CO_LOADQ(Qn, tq, h + 1);
            else if (item + G < nitems) { int b2, kh2, h02, res2, g2; CO_COORDS(item + G, b2, kh2, h02, res2, g2); (void)kh2;
                CO_LOADQ(Qn, (size_t)b2 * SEQ + res2 + (size_t)dil * (g2 * 256 + 32 * wave + r), h02); }
            v2u pa1[8], pa2[8]; float lse1 = 0.f, lse2 = 0.f;
            if constexpr (MODE == 2) { lse1 = LSE[tq * 16 + h]; lse2 = LSE[(size_t)M * 16 + tq * 16 + h];
#pragma unroll
                for (int db = 0; db < 2; ++db)
#pragma unroll
                    for (int g4 = 0; g4 < 4; ++g4) { const size_t off = ((size_t)h * M + tq) * HD + 32 * db + 8 * g4 + 4 * hi; pa1[db * 4 + g4] = *(const v2u*)(OB + off); pa2[db * 4 + g4] = *(const v2u*)(OB + (size_t)M * D + off); } }
            float m = 0.f, l = 0.f;
            if constexpr (KIND == 0) { m = sk[hs] * LOG2E; l = hi == 0 ? 1.0f : 0.0f; }
            f32x16 O0, O1;
#pragma unroll
            for (int i = 0; i < 16; ++i) { O0[i] = 0.f; O1[i] = 0.f; }
            const LAS unsigned char* tabb = (const LAS unsigned char*)(tabl + hs * AT_STRIDE) + tb0;
            int rbB = (i0 - W + 32 * tlo - lo) * 128;
            bf16x8 Kf[4];
#pragma unroll
            for (int st = 0; st < 4; ++st) Kf[st] = *(const LAS bf16x8*)(Kl + rbB + kfo[st]);
            f32x16 Sc = att_qk(Kf, Qf);
            const LAS unsigned char* kpn[4];
#pragma unroll
            for (int st = 0; st < 4; ++st) kpn[st] = Kl + rbB + 4096 + kfo[st];
            const LAS unsigned char* vpa = Vl + rbB + vo0; const LAS unsigned char* vpb = Vl + rbB + vo1;
            const LAS float* tp = (const LAS float*)(tabb + tlo * 128);
            asm volatile("" : "+v"(kpn[0]), "+v"(kpn[1]), "+v"(kpn[2]), "+v"(kpn[3]), "+v"(vpa), "+v"(vpb), "+v"(tp));
            for (int t = tlo; t < thi; ++t) {
                if (t + 1 < thi) {
#pragma unroll
                    for (int st = 0; st < 4; ++st) Kf[st] = *(const LAS bf16x8*)kpn[st]; }
                v4i16 Vt[8];
#pragma unroll
                for (int s2 = 0; s2 < 2; ++s2) {
                    Vt[(s2 * 2 + 0) * 2 + 0] = __builtin_amdgcn_ds_read_tr16_b64_v4i16((LAS v4i16*)(vpa + (16 * s2) * 128));
                    Vt[(s2 * 2 + 0) * 2 + 1] = __builtin_amdgcn_ds_read_tr16_b64_v4i16((LAS v4i16*)(vpa + (16 * s2 + 8) * 128));
                    Vt[(s2 * 2 + 1) * 2 + 0] = __builtin_amdgcn_ds_read_tr16_b64_v4i16((LAS v4i16*)(vpb + (16 * s2) * 128));
                    Vt[(s2 * 2 + 1) * 2 + 1] = __builtin_amdgcn_ds_read_tr16_b64_v4i16((LAS v4i16*)(vpb + (16 * s2 + 8) * 128)); }
                float bs[16];
#pragma unroll
                for (int i = 0; i < 16; ++i) bs[i] = tp[(i & 3) + 8 * (i >> 2)];
                __builtin_amdgcn_sched_barrier(0);
                f32x16 Sn = Sc;
                if (t + 1 < thi) Sn = att_qk(Kf, Qf);
                att_soft_pv(O0, O1, m, l, Sc, Vt, bs, lane);
                Sc = Sn;
#pragma unroll
                for (int st = 0; st < 4; ++st) kpn[st] += 4096;
                vpa += 4096; vpb += 4096; tp += 32;
            }
            if constexpr (MODE == 2) {
                const float lt = xor32_sum(l), inv = 1.0f / lt;
                const float lse3 = m + __builtin_amdgcn_logf(lt);
                const float mm = fmaxf(lse3, fmaxf(lse1, lse2)), w1 = __builtin_amdgcn_exp2f(lse1 - mm), w2 = __builtin_amdgcn_exp2f(lse2 - mm), w3 = __builtin_amdgcn_exp2f(lse3 - mm), wi = 1.0f / (w1 + w2 + w3);
                const float c1 = w1 * wi, c2 = w2 * wi, c3 = w3 * wi * inv;
#pragma unroll
                for (int db = 0; db < 2; ++db)
#pragma unroll
                    for (int g4 = 0; g4 < 4; ++g4) { const size_t off = tq * D + h * HD + 32 * db + 8 * g4 + 4 * hi;
                        const unsigned a1x = pa1[db * 4 + g4].x, a1y = pa1[db * 4 + g4].y, a2x = pa2[db * 4 + g4].x, a2y = pa2[db * 4 + g4].y;
                        const f32x16& O = db == 0 ? O0 : O1;
                        const float x0 = c3 * O[4 * g4 + 0] + c1 * bflo(a1x) + c2 * bflo(a2x), x1 = c3 * O[4 * g4 + 1] + c1 * bfhi(a1x) + c2 * bfhi(a2x);
                        const float x2 = c3 * O[4 * g4 + 2] + c1 * bflo(a1y) + c2 * bflo(a2y), x3 = c3 * O[4 * g4 + 3] + c1 * bfhi(a1y) + c2 * bfhi(a2y);
                        v2u w; w.x = pg8::cvt_pk_bf16(x0, x1); w.y = pg8::cvt_pk_bf16(x2, x3); *(v2u*)(AO + off) = w; }
            } else att_epilogue<MODE>(O0, O1, m, l, tq, h, hi, AO, OB, LSE, br);
        }
    }
#undef CO_COORDS
#undef CO_LOADQ
    __syncthreads();
}
__device__ __forceinline__ void attn_coopC_phase(const bf16* Qb, const bf16* Kb, const bf16* Vb, const float* biasT, bf16* AO, LAS unsigned char* lds, const int tid, const int vcu, const int G,
                                                 const int wave, const int lane) {
    (void)tid;
    constexpr int CV_OFF = 9 * 8192;
    LAS unsigned char* Kl = lds + RING_OFF; LAS unsigned char* Vl = lds + RING_OFF + CV_OFF; LAS float* tab = (LAS float*)(lds + TABB_OFF);
    const float* gtab = biasT + 65536 + 4 * 16 * AT_STRIDE;
    const int r = lane & 31, hi = lane >> 5, i16 = lane & 15, g4l = lane >> 4;
    int kfo[4];
#pragma unroll
    for (int st = 0; st < 4; ++st) kfo[st] = r * 128 + (((2 * st + hi) ^ (r & 7)) * 16);
    const int vrow = 4 * (g4l >> 1) + (i16 >> 2), vch = 2 * (g4l & 1) + ((i16 & 3) >> 1), vsw = 4 * ((i16 >> 3) & 1), vwi = 8 * (i16 & 1);
    const int vo0 = vrow * 128 + (vch + vsw) * 16 + vwi, vo1 = vrow * 128 + (vch + (4 - vsw)) * 16 + vwi;
    const int qb = wave & 3, part = wave >> 2;
    const int c0 = 16 * qb, cb = iclamp(c0 - 8, 0, 32), cq = c0 + (r & 15), csq = iclamp(cq - 8, 0, 48), w0 = csq - cb;
    float cneg[16];
#pragma unroll
    for (int i = 0; i < 16; ++i) cneg[i] = ((unsigned)(crow(i, hi) - w0) < 16u) ? 0.f : -1e30f;
    const int tb0 = 4 * (16 + (cb - cq + 15) + 4 * hi);
    LAS float* mrg = (LAS float*)(lds + MRG_OFF) + qb * 128 + lane * 2;
#define CC_LOADQ(Q_, tq_, h_) do { _Pragma("unroll") for (int st = 0; st < 4; ++st) Q_[st] = *(const bf16x8*)(Qb + ((size_t)(h_) * M + (tq_)) * HD + 16 * st + 8 * hi); } while (0)
    for (int band = vcu; band < BATCH * H * 2; band += G) {
        const int b = band >> 5, h = (band >> 1) & 15, half = band & 1;
        const char* kg = (const char*)Kb + ((size_t)h * M + (size_t)b * SEQ) * (HD * 2); const char* vg = (const char*)Vb + ((size_t)h * M + (size_t)b * SEQ) * (HD * 2);
        __syncthreads();
        if (wave < 2) __builtin_amdgcn_global_load_lds((const unsigned*)(gtab + (size_t)h * AT_STRIDE + wave * 256 + lane * 4), (LAS unsigned*)((LAS unsigned char*)tab + wave * 1024), 16, 0, 0);
        int have = -1;
        bf16x8 Qn[4];
        CC_LOADQ(Qn, (size_t)b * SEQ + (size_t)(32 * half + (r >> 4)) * 64 + c0 + (r & 15), h);
        for (int ip = 0; ip < 16; ++ip) {
            const int R = 32 * half + 2 * ip, lo = iclamp(R - 4, 0, 56), hir = iclamp(R - 3, 0, 56) + 7, thi = hir - lo + 1;
            if (ip) __syncthreads();
            { const int n0 = have + 1 > lo ? have + 1 : lo; const int col = 8 * wave + (lane >> 3), p = lane & 7;
              for (int kr = n0; kr <= hir; ++kr) { const int slot = kr % 9; const size_t off = (size_t)(kr * 64 + col) * (HD * 2);
                  __builtin_amdgcn_global_load_lds((const unsigned*)(kg + off + ((p ^ (lane >> 3)) * 16)), (LAS unsigned*)(Kl + slot * 8192 + wave * 1024), 16, 0, 0);
                  __builtin_amdgcn_global_load_lds((const unsigned*)(vg + off + ((p ^ (4 * ((lane >> 4) & 1))) * 16)), (LAS unsigned*)(Vl + slot * 8192 + wave * 1024), 16, 0, 0); }
              have = hir; }
            __builtin_amdgcn_s_waitcnt(0x0F70);
            __syncthreads();
            bf16x8 Qf[4];
#pragma unroll
            for (int st = 0; st < 4; ++st) Qf[st] = Qn[st];
            if (ip + 1 < 16) CC_LOADQ(Qn, (size_t)b * SEQ + (size_t)(R + 2 + (r >> 4)) * 64 + c0 + (r & 15), h);
            const size_t tq = (size_t)b * SEQ + (size_t)(R + (r >> 4)) * 64 + c0 + (r & 15);
            const int rq = R + (r >> 4), rsq = iclamp(rq - 4, 0, 56);
            const int nh = (thi + 1) >> 1, t0 = part ? nh : 0, t1 = part ? thi : nh;
            float m = 0.f, l = 0.f;
            f32x16 O0, O1;
#pragma unroll
            for (int i = 0; i < 16; ++i) { O0[i] = 0.f; O1[i] = 0.f; }
            bf16x8 Kf[4];
            { const int sb = ((lo + t0) % 9) * 8192 + cb * 128;
#pragma unroll
              for (int st = 0; st < 4; ++st) Kf[st] = *(const LAS bf16x8*)(Kl + sb + kfo[st]); }
            f32x16 Sc = att_qk(Kf, Qf);
            for (int t = t0; t < t1; ++t) {
                const int kr2 = lo + t, sb = (kr2 % 9) * 8192 + cb * 128;
                if (t + 1 < t1) { const int sbn = ((kr2 + 1) % 9) * 8192 + cb * 128;
#pragma unroll
                    for (int st = 0; st < 4; ++st) Kf[st] = *(const LAS bf16x8*)(Kl + sbn + kfo[st]); }
                v4i16 Vt[8];
#pragma unroll
                for (int s2 = 0; s2 < 2; ++s2) {
                    Vt[(s2 * 2 + 0) * 2 + 0] = __builtin_amdgcn_ds_read_tr16_b64_v4i16((LAS v4i16*)(Vl + sb + vo0 + (16 * s2) * 128));
                    Vt[(s2 * 2 + 0) * 2 + 1] = __builtin_amdgcn_ds_read_tr16_b64_v4i16((LAS v4i16*)(Vl + sb + vo0 + (16 * s2 + 8) * 128));
                    Vt[(s2 * 2 + 1) * 2 + 0] = __builtin_amdgcn_ds_read_tr16_b64_v4i16((LAS v4i16*)(Vl + sb + vo1 + (16 * s2) * 128));
                    Vt[(s2 * 2 + 1) * 2 + 1] = __builtin_amdgcn_ds_read_tr16_b64_v4i16((LAS v4i16*)(Vl + sb + vo1 + (16 * s2 + 8) * 128)); }
                float bt[16];
                { const LAS float* tp = (const LAS float*)((const LAS unsigned char*)tab + tb0 + 4 * 31 * iclamp(kr2 - rq + 7, 0, 14)); asm volatile("" : "+v"(tp));
#pragma unroll
                  for (int i = 0; i < 16; ++i) bt[i] = tp[(i & 3) + 8 * (i >> 2)]; }
                __builtin_amdgcn_sched_barrier(0);
                f32x16 Sn = Sc;
                if (t + 1 < t1) Sn = att_qk(Kf, Qf);
                float bs[16];
                { const float rneg = (kr2 >= rsq && kr2 < rsq + 8) ? 0.f : -1e30f;
#pragma unroll
                  for (int i = 0; i < 16; ++i) bs[i] = bt[i] + (cneg[i] + rneg); }
                att_soft_pv(O0, O1, m, l, Sc, Vt, bs, lane);
                Sc = Sn;
            }
            const float lt = xor32_sum(l);
            LAS unsigned char* hov = ((qb & 2) ? Vl : Kl) + ((thi == 8 ? lo + 8 : lo) % 9) * 8192 + (qb & 1) * 4096 + lane * 64;
            __syncthreads();
            if (part) {
                const float inv = lt > 0.f ? 1.0f / lt : 0.f;
#pragma unroll
                for (int db = 0; db < 2; ++db) { const f32x16& O = db == 0 ? O0 : O1;
#pragma unroll
                    for (int g2 = 0; g2 < 2; ++g2) { v4u w;
                        w.x = pg8::cvt_pk_bf16(O[8 * g2 + 0] * inv, O[8 * g2 + 1] * inv); w.y = pg8::cvt_pk_bf16(O[8 * g2 + 2] * inv, O[8 * g2 + 3] * inv);
                        w.z = pg8::cvt_pk_bf16(O[8 * g2 + 4] * inv, O[8 * g2 + 5] * inv); w.w = pg8::cvt_pk_bf16(O[8 * g2 + 6] * inv, O[8 * g2 + 7] * inv);
                        *(LAS v4u*)(hov + (db * 2 + g2) * 16) = w; } }
                mrg[0] = m; mrg[1] = lt;
            }
            __syncthreads();
            if (!part) {
                const float mb = mrg[0], lb = mrg[1];
                const float mm = fmaxf(m, mb), sa = __builtin_amdgcn_exp2f(m - mm), sb2 = __builtin_amdgcn_exp2f(mb - mm) * lb, invL = 1.0f / (lt * sa + sb2), ca = sa * invL, cbw = sb2 * invL;
#pragma unroll
                for (int db = 0; db < 2; ++db) { const f32x16& O = db == 0 ? O0 : O1;
#pragma unroll
                    for (int g2 = 0; g2 < 2; ++g2) { const v4u pw = *(const LAS v4u*)(hov + (db * 2 + g2) * 16);
                        const unsigned p0 = pw.x, p1 = pw.y, p2 = pw.z, p3 = pw.w;
                        const float x0 = O[8 * g2 + 0] * ca + bflo(p0) * cbw, x1 = O[8 * g2 + 1] * ca + bfhi(p0) * cbw, x2 = O[8 * g2 + 2] * ca + bflo(p1) * cbw, x3 = O[8 * g2 + 3] * ca + bfhi(p1) * cbw;
                        const float x4 = O[8 * g2 + 4] * ca + bflo(p2) * cbw, x5 = O[8 * g2 + 5] * ca + bfhi(p2) * cbw, x6 = O[8 * g2 + 6] * ca + bflo(p3) * cbw, x7 = O[8 * g2 + 7] * ca + bfhi(p3) * cbw;
                        { v2u w; w.x = pg8::cvt_pk_bf16(x0, x1); w.y = pg8::cvt_pk_bf16(x2, x3); *(v2u*)(AO + tq * D + h * HD + 32 * db + 8 * (2 * g2) + 4 * hi) = w; }
                        { v2u w; w.x = pg8::cvt_pk_bf16(x4, x5); w.y = pg8::cvt_pk_bf16(x6, x7); *(v2u*)(AO + tq * D + h * HD + 32 * db + 8 * (2 * g2 + 1) + 4 * hi) = w; } } }
            }
        }
    }
#undef CC_LOADQ
    __syncthreads();
}
template <int KIND, int MODE, bool NOLOAD = false>
__device__ __forceinline__ void attn_phase_mfma(const bf16* Qb, const bf16* Kb, const bf16* Vb, const float* biasT, const float* extra, bf16* AO, bf16* OB, float* LSE,
                                                const int br, const int dil, LAS unsigned char* lds, const int gw, const int NGW, const int wave, const int lane) {
    LAS unsigned char* wl = lds + RING_OFF + wave * AW_BYTES;
    LAS float* tabs = (LAS float*)(lds + RING_OFF + AT_OFF);
    __syncthreads();
    { const int tbid = KIND == 0 ? 0 : (KIND == 2 ? 4 : (dil == 16 ? 1 : (dil == 4 ? 2 : 3)));
      const v4u* src = (const v4u*)(biasT + 65536 + tbid * 16 * AT_STRIDE); v4u tv[4];
#pragma unroll
      for (int k = 0; k < 4; ++k) tv[k] = src[wave * 64 + lane + NWAVES * 64 * k];
#pragma unroll
      for (int k = 0; k < 4; ++k) ((LAS v4u*)tabs)[wave * 64 + lane + NWAVES * 64 * k] = tv[k]; }
    __syncthreads();
    for (int wi = gw; wi < (M / 32) * H; wi += NGW) {
        AttItem it; const int bh = wi >> 7, idx = wi & 127;
        it.b = bh >> 4; it.h = bh & 15; it.kh = KIND == 0 ? (it.h >> 2) : it.h; it.dil = dil; it.res = 0; it.L = SEQ; it.R = 0; it.c0 = 0; it.cb = 0; it.rs0 = 0; it.q0 = 0;
        if constexpr (KIND == 0) { it.q0 = idx * 32; it.tlo = it.q0 < 128 ? (128 - it.q0) / 32 : 0; const int th = (SEQ + 128 - it.q0) / 32; it.thi = th < 9 ? th : 9; }
        else if constexpr (KIND == 1) { it.L = SEQ / dil; const int nb = it.L / 32; it.res = idx / nb; it.q0 = (idx % nb) * 32; it.tlo = it.q0 < 64 ? (64 - it.q0) / 32 : 0; const int th = (it.L + 64 - it.q0) / 32; it.thi = th < 5 ? th : 5; }
        else { it.R = (idx >> 2) * 2; it.c0 = (idx & 3) * 16; it.cb = iclamp(it.c0 - 8, 0, 32); it.rs0 = iclamp(it.R - 4, 0, 56); it.tlo = 0; it.thi = iclamp(it.R + 1 - 4, 0, 56) + 8 - it.rs0; }
        if (MK_DRYA == 6 && NOLOAD) it.thi = it.tlo + 1;
        attn_item<KIND, MODE, NOLOAD>(it, Qb, Kb, Vb, KIND == 0 ? 256 : D, biasT, extra, AO, OB, LSE, br, wl, tabs, lane);
    }
}

#define LN_STATS(v, mean, rstd) do { float s_ = 0.f; _Pragma("unroll") for (int j_ = 0; j_ < 4; ++j_) s_ += (v[j_].x + v[j_].y) + (v[j_].z + v[j_].w); \
        mean = wave_sum(s_) * (1.f / D); float s2_ = 0.f; \
        _Pragma("unroll") for (int j_ = 0; j_ < 4; ++j_) { const f32x4 d_ = v[j_] - mean; s2_ += (d_.x * d_.x + d_.y * d_.y) + (d_.z * d_.z + d_.w * d_.w); } \
        rstd = 1.0f / sqrtf(wave_sum(s2_) * (1.f / D) + LN_EPS); } while (0)

__device__ __forceinline__ int lane_get(int v, int src, int lane) { (void)lane; return __builtin_amdgcn_ds_bpermute(src << 2, v); }
__device__ __forceinline__ float lane_getf(float v, int src) { return __builtin_bit_cast(float, __builtin_amdgcn_ds_bpermute(src << 2, __builtin_bit_cast(int, v))); }
constexpr float LN1_WSC = 256.f, LN1_XSC = 64.f, LN1_DSC = 1.f / (256.f * 64.f);
__device__ __forceinline__ v2u split2h(float a, float b) {
    f16x2 h; h.x = (_Float16)a; h.y = (_Float16)b;
    f16x2 l; l.x = (_Float16)(a - (float)h.x); l.y = (_Float16)(b - (float)h.y);
    v2u o; o.x = __builtin_bit_cast(unsigned, h); o.y = __builtin_bit_cast(unsigned, l); return o;
}
#define LN1_SPLIT8(H_, L_, t_, sc_) do { const v2u p0_ = split2h((t_)[0] * (sc_), (t_)[1] * (sc_)), p1_ = split2h((t_)[2] * (sc_), (t_)[3] * (sc_)), p2_ = split2h((t_)[4] * (sc_), (t_)[5] * (sc_)), p3_ = split2h((t_)[6] * (sc_), (t_)[7] * (sc_)); \
        (H_).x = p0_.x; (H_).y = p1_.x; (H_).z = p2_.x; (H_).w = p3_.x; (L_).x = p0_.y; (L_).y = p1_.y; (L_).z = p2_.y; (L_).w = p3_.y; } while (0)
constexpr int LN1_PS = 52;
__device__ __forceinline__ void ln1_router_phase(const bf16* hin, const bf16* Y, const LayerP& P, bf16* hb, unsigned* cntw, int* tok2, unsigned* ti,
                                                 LAS unsigned char* lds, int tid, int vcu, int G, int lane, int wave) {
    const int r = lane & 15, q = lane >> 4, cb = 128 * wave + 8 * q;
    LAS float* gL = (LAS float*)(lds + VO_OFF);
    LAS float* st1 = (LAS float*)(lds + RING_OFF); LAS float* st2 = st1 + 128; LAS float* part = st1 + 256;
    v4u hw[4], yw[4];
#define LN1_LOAD(g_) do { const size_t o_ = (size_t)((g_) * 16 + r) * D + cb; _Pragma("unroll") for (int s = 0; s < 4; ++s) { hw[s] = *(const v4u*)(hin + o_ + 32 * s); yw[s] = *(const v4u*)(Y + o_ + 32 * s); } } while (0)
    const int NG = M / 16;
    if (vcu < NG) LN1_LOAD(vcu);
    const f32x4 gb4 = tid < 256 ? ((const f32x4*)P.ln1g)[tid] : ((const f32x4*)P.ln1b)[tid - 256];
    v4u WH[3][4], WL[3][4];
#pragma unroll
    for (int s = 0; s < 4; ++s) {
        float t0[8], t1[8], t2[8];
#pragma unroll
        for (int j = 0; j < 8; ++j) { const int col = cb + 32 * s + j; t0[j] = P.rew[col * 32 + r]; t1[j] = P.rew[col * 32 + 16 + r]; t2[j] = P.rgw[col * 4 + (r & 3)]; }
        if (r >= 4) {
#pragma unroll
            for (int j = 0; j < 8; ++j) t2[j] = 0.f; }
        LN1_SPLIT8(WH[0][s], WL[0][s], t0, LN1_WSC); LN1_SPLIT8(WH[1][s], WL[1][s], t1, LN1_WSC); LN1_SPLIT8(WH[2][s], WL[2][s], t2, LN1_WSC);
    }
    const float reb_e = P.reb[lane & 31], rgb_e = P.rgb[lane & 3];
    ((LAS f32x4*)gL)[tid] = gb4;
    LAS unsigned* cntL = (LAS unsigned*)(lds + RING_OFF + 61440);
    if (tid < 64) cntL[tid] = 0u;
    __syncthreads();
    int me0 = 0, me1 = 0, mt = 0; float mg0 = 0.f, mg1 = 0.f; int it = 0;
    for (int gi = vcu; gi < NG; gi += G, ++it) {
        const size_t o = (size_t)(gi * 16 + r) * D + cb;
        float v[32];
#pragma unroll
        for (int s = 0; s < 4; ++s) { const unsigned y0 = yw[s].x, y1 = yw[s].y, y2 = yw[s].z, y3 = yw[s].w, h0 = hw[s].x, h1 = hw[s].y, h2 = hw[s].z, h3 = hw[s].w;
            v[8 * s + 0] = ALPHA * hlo(h0) + bflo(y0); v[8 * s + 1] = ALPHA * hhi(h0) + bfhi(y0); v[8 * s + 2] = ALPHA * hlo(h1) + bflo(y1); v[8 * s + 3] = ALPHA * hhi(h1) + bfhi(y1);
            v[8 * s + 4] = ALPHA * hlo(h2) + bflo(y2); v[8 * s + 5] = ALPHA * hhi(h2) + bfhi(y2); v[8 * s + 6] = ALPHA * hlo(h3) + bflo(y3); v[8 * s + 7] = ALPHA * hhi(h3) + bfhi(y3); }
        if (gi + G < NG) LN1_LOAD(gi + G);
        float s1 = 0.f;
#pragma unroll
        for (int kk = 0; kk < 32; kk += 4) s1 += (v[kk] + v[kk + 1]) + (v[kk + 2] + v[kk + 3]);
        float s2 = 0.f;
        { const float ml = s1 * (1.f / 32.f);
#pragma unroll
          for (int kk = 0; kk < 32; kk += 2) { const float d0 = v[kk] - ml, d1 = v[kk + 1] - ml; s2 += d0 * d0 + d1 * d1; } }
        { const float so = lane_getf(s1, lane ^ 16), mo = lane_getf(s2, lane ^ 16), dd = (s1 - so) * (1.f / 32.f); s2 += mo + 16.f * dd * dd; s1 += so; }
        { const float so = lane_getf(s1, lane ^ 32), mo = lane_getf(s2, lane ^ 32), dd = (s1 - so) * (1.f / 64.f); s2 += mo + 32.f * dd * dd; s1 += so; }
        if (q == 0) { st1[wave * 16 + r] = s1; st2[wave * 16 + r] = s2; }
        __syncthreads();
        float mean = 0.f, var = 0.f;
        { float sw[8];
#pragma unroll
          for (int w = 0; w < 8; ++w) { sw[w] = st1[w * 16 + r]; mean += sw[w]; var += st2[w * 16 + r]; }
          mean *= (1.f / D);
#pragma unroll
          for (int w = 0; w < 8; ++w) { const float dd = sw[w] * (1.f / 128.f) - mean; var += 128.f * dd * dd; } }
        const float rstd = 1.0f / sqrtf(var * (1.f / D) + LN_EPS);
#pragma unroll
        for (int s = 0; s < 4; ++s) { const int c4 = (cb + 32 * s) >> 2;
            const f32x4 ga = ((const LAS f32x4*)gL)[c4], gb = ((const LAS f32x4*)gL)[c4 + 1], ba = ((const LAS f32x4*)gL)[256 + c4], bb = ((const LAS f32x4*)gL)[256 + c4 + 1];
            f32x4 xa, xb;
            xa.x = (v[8 * s + 0] - mean) * rstd * ga.x + ba.x; xa.y = (v[8 * s + 1] - mean) * rstd * ga.y + ba.y; xa.z = (v[8 * s + 2] - mean) * rstd * ga.z + ba.z; xa.w = (v[8 * s + 3] - mean) * rstd * ga.w + ba.w;
            xb.x = (v[8 * s + 4] - mean) * rstd * gb.x + bb.x; xb.y = (v[8 * s + 5] - mean) * rstd * gb.y + bb.y; xb.z = (v[8 * s + 6] - mean) * rstd * gb.z + bb.z; xb.w = (v[8 * s + 7] - mean) * rstd * gb.w + bb.w;
            v4u w; w.x = pkh(xa.x, xa.y); w.y = pkh(xa.z, xa.w); w.z = pkh(xb.x, xb.y); w.w = pkh(xb.z, xb.w); *(v4u*)(hb + o + 32 * s) = w;
            v[8 * s + 0] = xa.x; v[8 * s + 1] = xa.y; v[8 * s + 2] = xa.z; v[8 * s + 3] = xa.w; v[8 * s + 4] = xb.x; v[8 * s + 5] = xb.y; v[8 * s + 6] = xb.z; v[8 * s + 7] = xb.w; }
        f32x4 a0 = {0.f, 0.f, 0.f, 0.f}, a1 = a0, a2 = a0;
#pragma unroll
        for (int s = 0; s < 4; ++s) { v4u xh, xl;
            LN1_SPLIT8(xh, xl, v + 8 * s, LN1_XSC);
            const f16x8 XH = __builtin_bit_cast(f16x8, xh), XL = __builtin_bit_cast(f16x8, xl);
            a0 = __builtin_amdgcn_mfma_f32_16x16x32_f16(XH, __builtin_bit_cast(f16x8, WH[0][s]), a0, 0, 0, 0); a1 = __builtin_amdgcn_mfma_f32_16x16x32_f16(XH, __builtin_bit_cast(f16x8, WH[1][s]), a1, 0, 0, 0);
            a2 = __builtin_amdgcn_mfma_f32_16x16x32_f16(XH, __builtin_bit_cast(f16x8, WH[2][s]), a2, 0, 0, 0);
            a0 = __builtin_amdgcn_mfma_f32_16x16x32_f16(XL, __builtin_bit_cast(f16x8, WH[0][s]), a0, 0, 0, 0); a1 = __builtin_amdgcn_mfma_f32_16x16x32_f16(XL, __builtin_bit_cast(f16x8, WH[1][s]), a1, 0, 0, 0);
            a2 = __builtin_amdgcn_mfma_f32_16x16x32_f16(XL, __builtin_bit_cast(f16x8, WH[2][s]), a2, 0, 0, 0);
            a0 = __builtin_amdgcn_mfma_f32_16x16x32_f16(XH, __builtin_bit_cast(f16x8, WL[0][s]), a0, 0, 0, 0); a1 = __builtin_amdgcn_mfma_f32_16x16x32_f16(XH, __builtin_bit_cast(f16x8, WL[1][s]), a1, 0, 0, 0);
            a2 = __builtin_amdgcn_mfma_f32_16x16x32_f16(XH, __builtin_bit_cast(f16x8, WL[2][s]), a2, 0, 0, 0); }
        a0 *= LN1_DSC; a1 *= LN1_DSC; a2 *= LN1_DSC;
        { LAS float* pw = part + wave * (16 * LN1_PS) + (4 * q) * LN1_PS + r;
#pragma unroll
          for (int i = 0; i < 4; ++i) { pw[i * LN1_PS] = a0[i]; pw[i * LN1_PS + 16] = a1[i]; pw[i * LN1_PS + 32] = a2[i]; } }
        __syncthreads();
        { const int half = lane >> 5, e = lane & 31, tk = 2 * wave + half;
          const LAS float* pr = part + tk * LN1_PS;
          float le_ = 0.f, lg_ = 0.f;
#pragma unroll
          for (int w = 0; w < 8; ++w) { le_ += pr[w * (16 * LN1_PS) + e]; lg_ += pr[w * (16 * LN1_PS) + 32 + (e & 3)]; }
          le_ += reb_e; lg_ += rgb_e;
          float lg[4];
#pragma unroll
          for (int c = 0; c < 4; ++c) lg[c] = lane_getf(lg_, (lane & 32) + c);
          int grp = 0; float lmax = lg[0];
#pragma unroll
          for (int i = 1; i < 4; ++i) if (lg[i] > lmax) { lmax = lg[i]; grp = i; }
          float den = 0.f;
#pragma unroll
          for (int i = 0; i < 4; ++i) den += expf(lg[i] - lmax);
          const float pg = 1.0f / den;
          float le[8];
#pragma unroll
          for (int i = 0; i < 8; ++i) le[i] = lane_getf(le_, (lane & 32) + grp * 8 + i);
          int i0 = 0; float v0 = le[0];
#pragma unroll
          for (int i = 1; i < 8; ++i) if (le[i] > v0) { v0 = le[i]; i0 = i; }
          int i1 = -1; float v1 = -3.0e38f;
#pragma unroll
          for (int i = 0; i < 8; ++i) if (i != i0 && le[i] > v1) { v1 = le[i]; i1 = i; }
          const float dd = expf(v1 - v0), g0 = pg / (1.0f + dd), g1 = pg * dd / (1.0f + dd);
          if (e == it) { me0 = grp * 8 + i0; me1 = grp * 8 + i1; mg0 = g0; mg1 = g1; mt = gi * 16 + tk; } }
    }
#undef LN1_LOAD
    { const int row = lane >> 1, slot = lane & 1, srcl = (row >> 1) + 32 * (row & 1);
      const int e0r = lane_get(me0, srcl, lane), e1r = lane_get(me1, srcl, lane), tr = lane_get(mt, srcl, lane);
      const float g0r = lane_getf(mg0, srcl), g1r = lane_getf(mg1, srcl);
      const bool act = row < 2 * it; const int e = slot ? e1r : e0r;
      unsigned rank = 0u;
      if (act) rank = __hip_atomic_fetch_add(cntL + e, 1u, __ATOMIC_RELAXED, __HIP_MEMORY_SCOPE_WORKGROUP);
      LDS_WAIT(); __syncthreads();
      if (tid < 32) { const unsigned c = cntL[tid]; cntL[32 + tid] = c ? __hip_atomic_fetch_add(cntw + tid * 32, c, RLX_AGENT) : 0u; }
      __syncthreads();
      if (act) { rank += cntL[32 + e]; tok2[(size_t)e * 32768 + rank] = tr; }
      const unsigned rother = (unsigned)lane_get((int)rank, lane ^ 1, lane);
      if (act && slot == 0) { v4u a; a.x = (unsigned)e0r; a.y = (unsigned)e1r; a.z = rank; a.w = rother; ((v4u*)ti)[2 * tr] = a;
                              f32x2 gq; gq.x = g0r; gq.y = g1r; ((f32x2*)(ti + 8 * M))[tr] = gq; } }
    __syncthreads();
}
__device__ __forceinline__ void build_moe_tables(unsigned* cntw, LAS unsigned char* lds, int tid) {
    LAS int* tb = (LAS int*)(lds + TB_OFF); LAS int* cnt = (LAS int*)(lds + CNT_OFF);
    __syncthreads();
    if (tid < 64) {
        const int e = tid & 31, c = (int)__hip_atomic_load(cntw + e * 32, RLX_AGENT), nt = (c + 255) >> 8;
        int incl = nt;
#pragma unroll
        for (int d = 1; d < 32; d <<= 1) { const int o = __builtin_amdgcn_ds_bpermute(((tid & 32) + ((e - d) & 31)) << 2, incl); if (e >= d) incl += o; }
        if (tid < 32) { cnt[e] = c; tb[e] = incl - nt; if (e == 31) tb[32] = incl; }
    }
    __syncthreads();
    if (tid < 320) { int e = 0;
#pragma unroll
        for (int j = 1; j < 32; ++j) e += (tb[j] <= tid) ? 1 : 0;
        const int k = tid - tb[e]; int nv = cnt[e] - k * 256; nv = nv > 256 ? 256 : (nv < 0 ? 0 : nv); ((LAS unsigned*)(lds + TE_OFF))[tid] = (unsigned)e | ((unsigned)nv << 8) | ((unsigned)(k & 0xfff) << 20); }
    __syncthreads();
}
__device__ __forceinline__ void ln2_combine_phase(const bf16* hio, float* hout2, const bool wr32, const bf16* YS, const LayerP& P, bf16* hb, const unsigned* ti, LAS unsigned char* lds, int gw, int NGW, int lane) {
    const LAS int* tb = (const LAS int*)(lds + TB_OFF);
    const f32x4* g4 = (const f32x4*)P.ln2g; const f32x4* b4 = (const f32x4*)P.ln2b;
    v4u ra = {0u, 0u, 0u, 0u}; f32x2 rg = {0.f, 0.f};
    { const int tl = gw + lane * NGW; if (tl < M) { ra = ((const v4u*)ti)[2 * tl]; rg = ((const f32x2*)(ti + 8 * M))[tl]; } }
    const float rgxf = rg.x, rgyf = rg.y; const int rgx = __builtin_bit_cast(int, rgxf), rgy = __builtin_bit_cast(int, rgyf);
    f32x4 gr[4], br_[4];
#pragma unroll
    for (int j = 0; j < 4; ++j) { gr[j] = g4[64 * j + lane]; br_[j] = b4[64 * j + lane]; }
    v2u hw[4], y0[4], y1[4];
#define LN2_LOAD(k_, t_) do { const int e0_ = __builtin_amdgcn_readlane((int)ra.x, (k_)), e1_ = __builtin_amdgcn_readlane((int)ra.y, (k_)); \
        const size_t s0_ = (size_t)__builtin_amdgcn_readfirstlane(tb[e0_]) * 256 + (unsigned)__builtin_amdgcn_readlane((int)ra.z, (k_)), s1_ = (size_t)__builtin_amdgcn_readfirstlane(tb[e1_]) * 256 + (unsigned)__builtin_amdgcn_readlane((int)ra.w, (k_)); \
        _Pragma("unroll") for (int j = 0; j < 4; ++j) { hw[j] = ((const v2u*)(hio + (size_t)(t_) * D))[64 * j + lane]; y0[j] = ((const v2u*)(YS + s0_ * D))[64 * j + lane]; y1[j] = ((const v2u*)(YS + s1_ * D))[64 * j + lane]; } } while (0)
    int k = 0;
    if (gw < M) LN2_LOAD(0, gw);
    for (int t = gw; t < M; t += NGW, ++k) {
        const float g0 = __builtin_bit_cast(float, __builtin_amdgcn_readlane(rgx, k)), g1 = __builtin_bit_cast(float, __builtin_amdgcn_readlane(rgy, k));
        f32x4 v[4];
#pragma unroll
        for (int j = 0; j < 4; ++j) {
            const unsigned h0 = hw[j].x, h1 = hw[j].y;
            v[j].x = ALPHA * hlo(h0) + (g0 * bflo(y0[j].x) + g1 * bflo(y1[j].x)); v[j].y = ALPHA * hhi(h0) + (g0 * bfhi(y0[j].x) + g1 * bfhi(y1[j].x));
            v[j].z = ALPHA * hlo(h1) + (g0 * bflo(y0[j].y) + g1 * bflo(y1[j].y)); v[j].w = ALPHA * hhi(h1) + (g0 * bfhi(y0[j].y) + g1 * bfhi(y1[j].y)); }
        if (t + NGW < M) LN2_LOAD(k + 1, t + NGW);
        float mean, rstd; LN_STATS(v, mean, rstd);
#pragma unroll
        for (int j = 0; j < 4; ++j) { v[j] = (v[j] - mean) * rstd * gr[j] + br_[j];
            if (wr32) ((f32x4*)(hout2 + (size_t)t * D))[64 * j + lane] = v[j];
            else { v2u w; w.x = pkh(v[j].x, v[j].y); w.y = pkh(v[j].z, v[j].w); ((v2u*)(hb + (size_t)t * D))[64 * j + lane] = w; } }
    }
#undef LN2_LOAD
}

#ifndef MK_VERIFY
#define MK_VERIFY 0
#endif
__device__ __forceinline__ float bfr(float x) { return bflo(f2bf(x)); }
__device__ __forceinline__ float bfld(const bf16* p) { return bflo((unsigned)*p); }
__device__ __forceinline__ void vfail(unsigned* ctl, int code) { atomicAdd(ctl + 64 + code, 1u); }
__device__ __forceinline__ bool vbad(float ref, float got) { return !(fabsf(ref - got) <= 0.02f * fabsf(ref) + 1e-3f); }

#if MK_VERIFY
constexpr size_t WS_SNAP = 576 * MiB;
__device__ __forceinline__ void verify_phase(const Args& args, int ph, unsigned char* ws, LAS unsigned char* lds, int tid, int bx) {
    unsigned* ctl = (unsigned*)(ws + WS_CTL);
    const float* biasT = (const float*)(ws + WS_BIAS); (void)biasT;
    const bf16* HB = (const bf16*)(ws + WS_HB); const bf16* QB = (const bf16*)(ws + WS_Q); const bf16* KB = (const bf16*)(ws + WS_K); const bf16* VB = (const bf16*)(ws + WS_V); const bf16* AO = (const bf16*)(ws + WS_AO);
    const bf16* YB = (const bf16*)(ws + WS_Y); const bf16* ACT = (const bf16*)(ws + WS_ACT); const bf16* YS = (const bf16*)(ws + WS_YS);
    const int* tok2 = (const int*)(ws + WS_TOK2); const unsigned* ti = (const unsigned*)(ws + WS_TI); const float* snap = (const float*)(ws + WS_SNAP);
    if (ph == 0) { if (bx < 4) vfail(ctl, 40); return; }
    const int l = (ph - 1) / 7, s = (ph - 1) % 7, kind = (l == 1) ? 1 : (l == 2) ? 2 : 0;
    const int kvw = kind == 0 ? 256 : 1024, nqkv = 1024 + 2 * kvw;
    const LayerP& P = args.L[l];
    unsigned* cntw = ctl + CW_CNT + l * 32 * 32;
    const unsigned hs = (unsigned)(bx * 512 + tid) * 2654435761u + (unsigned)l * 977u + (unsigned)s * 131u;
    const int t = (int)(hs % (unsigned)M);
    if (s == 0) {
        const int n = (int)((hs >> 7) % (unsigned)nqkv);
        float a = 0.f; for (int k = 0; k < D; ++k) a += bfld(HB + (size_t)t * D + k) * bfr(P.wqkv[(size_t)k * nqkv + n]);
        float got; if (n < 1024) { a *= 0.125f; got = bfld(QB + (size_t)t * D + n); } else if (n < 1024 + kvw) got = bfld(KB + (size_t)t * kvw + (n - 1024)); else got = bfld(VB + (size_t)t * kvw + (n - 1024 - kvw));
        if (vbad(a, got)) vfail(ctl, l * 8 + 1);
    } else if (s == 1) {
        const int h = (int)((hs >> 7) & 15u), d = (int)((hs >> 11) & 63u), b = t >> 12, pos = t & 4095;
        const bf16* qr = QB + (size_t)t * D + h * HD;
        const int kh = kind == 0 ? (h >> 2) : h;
        const int nk = kind == 0 ? 257 : (kind == 1 ? 387 : 128);
        const int r = pos >> 6, c = pos & 63, rs = r - 4 < 0 ? 0 : (r - 4 > 56 ? 56 : r - 4), cs = c - 8 < 0 ? 0 : (c - 8 > 48 ? 48 : c - 8);
        float mx = kind == 0 ? P.extra[h] : -3.0e38f, den = 0.f, num = 0.f;
        for (int pass = 0; pass < 2; ++pass) {
            for (int i = 0; i < nk; ++i) {
                int j; float bias;
                if (kind == 0) { j = pos - 128 + i; bias = args.t5[t5_bucket(j - pos) * 16 + h]; }
                else if (kind == 1) { const int br = i / 129, mm = i % 129 - 64, dil = br == 0 ? 1 : (br == 1 ? 4 : 16); j = pos + dil * mm; bias = args.t5[t5_bucket(dil * mm) * 16 + h]; }
                else { const int rr = rs + i / 16, cc = cs + i % 16; int dc = cc - c; dc = dc < -15 ? -15 : (dc > 15 ? 15 : dc); j = rr * 64 + cc; bias = P.extra[h * 465 + (rr - r + 7) * 31 + dc + 15]; }
                if (j < 0 || j >= SEQ) continue;
                const bf16* kr = KB + ((size_t)(b * SEQ + j)) * kvw + kh * HD;
                float sc = 0.f; for (int e = 0; e < HD; ++e) sc += bfld(qr + e) * bfld(kr + e);
                sc += bias;
                if (pass == 0) mx = fmaxf(mx, sc);
                else { const float p = expf(sc - mx); den += p; num += p * bfld(VB + ((size_t)(b * SEQ + j)) * kvw + kh * HD + d); }
            }
            if (pass == 0 && kind == 0) den = expf(P.extra[h] - mx);
        }
        if (vbad(num / den, bfld(AO + (size_t)t * D + h * HD + d))) { vfail(ctl, l * 8 + 2);
            if (l == 0) { atomicAdd(ctl + 128, 1u); if (pos < 160 || pos >= SEQ - 160) atomicAdd(ctl + 129, 1u); if (d >= 32) atomicAdd(ctl + 130, 1u); if (d & 4) atomicAdd(ctl + 131, 1u); } }
    } else if (s == 2) {
        const int n = (int)((hs >> 7) % (unsigned)D);
        float a = 0.f; for (int k = 0; k < D; ++k) a += bfld(AO + (size_t)t * D + k) * bfr(P.wo[(size_t)k * D + n]);
        if (vbad(a, bfld(YB + (size_t)t * D + n))) vfail(ctl, l * 8 + 3);
    } else if (s == 3 || s == 6) {
        const float* xin = (s == 3 && l == 0) ? args.x : snap;
        const float* gg = s == 3 ? P.ln1g : P.ln2g; const float* bb = s == 3 ? P.ln1b : P.ln2b;
        const v4u a4 = ((const v4u*)ti)[2 * t]; const f32x2 gq0 = ((const f32x2*)(ti + 8 * M))[t];
        const LAS int* tb = (const LAS int*)(lds + TB_OFF);
        const size_t s0 = (size_t)tb[a4.x & 31] * 256 + a4.z, s1 = (size_t)tb[a4.y & 31] * 256 + a4.w;
        const float g0 = gq0.x, g1 = gq0.y;
        float sum = 0.f;
        for (int d = 0; d < D; ++d) { const float y = s == 3 ? bfld(YB + (size_t)t * D + d) : (g0 * bfld(YS + s0 * D + d) + g1 * bfld(YS + s1 * D + d)); sum += ALPHA * xin[(size_t)t * D + d] + y; }
        const float mean = sum / D; float sq = 0.f;
        for (int d = 0; d < D; ++d) { const float y = s == 3 ? bfld(YB + (size_t)t * D + d) : (g0 * bfld(YS + s0 * D + d) + g1 * bfld(YS + s1 * D + d)); const float v = ALPHA * xin[(size_t)t * D + d] + y - mean; sq += v * v; }
        const float rstd = 1.0f / sqrtf(sq / D + LN_EPS);
        bool bad = false; float lg[4] = {0.f, 0.f, 0.f, 0.f};
        for (int d = 0; d < D; ++d) { const float y = s == 3 ? bfld(YB + (size_t)t * D + d) : (g0 * bfld(YS + s0 * D + d) + g1 * bfld(YS + s1 * D + d));
            const float o = (ALPHA * xin[(size_t)t * D + d] + y - mean) * rstd * gg[d] + bb[d]; const float got = args.out[(size_t)t * D + d];
            if (!(fabsf(o - got) <= 2e-3f)) bad = true; if (vbad(got, bfld(HB + (size_t)t * D + d))) bad = true;
            if (s == 3) { for (int i = 0; i < 4; ++i) lg[i] += got * P.rgw[d * 4 + i]; } }
        if (bad) vfail(ctl, l * 8 + (s == 3 ? 4 : 8));
        if (s == 3) {
            for (int i = 0; i < 4; ++i) lg[i] += P.rgb[i];
            int grp = 0; for (int i = 1; i < 4; ++i) if (lg[i] > lg[grp]) grp = i;
            float gap = 1e30f; for (int i = 0; i < 4; ++i) if (i != grp) gap = fminf(gap, lg[grp] - lg[i]);
            float den = 0.f; for (int i = 0; i < 4; ++i) den += expf(lg[i] - lg[grp]);
            const int e0 = (int)a4.x, e1 = (int)a4.y;
            bool rb = false; int gateok = 1;
            if ((e0 >> 3) != grp || (e1 >> 3) != grp) { if (gap > 1e-3f) { rb = true; } }
            else {
                float le[8]; for (int i = 0; i < 8; ++i) le[i] = 0.f;
                for (int d = 0; d < D; ++d) { const float got = args.out[(size_t)t * D + d]; for (int i = 0; i < 8; ++i) le[i] += got * P.rew[d * 32 + grp * 8 + i]; }
                for (int i = 0; i < 8; ++i) le[i] += P.reb[grp * 8 + i];
                int i0 = 0; for (int i = 1; i < 8; ++i) if (le[i] > le[i0]) i0 = i;
                int i1 = -1; for (int i = 0; i < 8; ++i) if (i != i0 && (i1 < 0 || le[i] > le[i1])) i1 = i;
                float third = -3e38f; for (int i = 0; i < 8; ++i) if (i != i0 && i != i1) third = fmaxf(third, le[i]);
                const bool near = (le[i1] - third < 1e-3f) || (le[i0] - le[i1] < 1e-3f);
                if ((e0 != grp * 8 + i0 || e1 != grp * 8 + i1) && !near) { rb = true; }
                if (e0 == grp * 8 + i0 && e1 == grp * 8 + i1) { const f32x2 gq = ((const f32x2*)(ti + 8 * M))[t]; const float dd = expf(le[i1] - le[i0]), pg = 1.0f / den;
                    if (!(fabsf(gq.x - pg / (1.f + dd)) < 1e-3f) || !(fabsf(gq.y - pg * dd / (1.f + dd)) < 1e-3f)) gateok = 0; }
            }
            if (e0 < 0 || e0 > 31 || e1 < 0 || e1 > 31 || e0 == e1) { rb = true; }
            if (gateok == 0) rb = true;
            if (tok2[(size_t)(e0 & 31) * 32768 + a4.z] != t || tok2[(size_t)(e1 & 31) * 32768 + a4.w] != t) { rb = true; }
            if (rb) vfail(ctl, l * 8 + 5);
        }
    } else if (s == 4) {
        const int ks = (int)((hs >> 5) & 1u), c = (int)((hs >> 7) % (unsigned)DEXP);
        const v4u a4 = ((const v4u*)ti)[2 * t]; const int e = (ks ? (int)a4.y : (int)a4.x) & 31, r = ks ? (int)a4.w : (int)a4.z;
        const size_t slot = (size_t)((const LAS int*)(lds + TB_OFF))[e] * 256 + r;
        float g = 0.f, u = 0.f; for (int k = 0; k < D; ++k) { const float xv = bfld(HB + (size_t)t * D + k); g += xv * bfr(P.wg[((size_t)e * D + k) * DEXP + c]); u += xv * bfr(P.wu[((size_t)e * D + k) * DEXP + c]); }
        const float ref = g / (1.0f + expf(-g)) * u;
        if (r < 0 || r >= ((const LAS int*)(lds + CNT_OFF))[e] || vbad(ref, bfld(ACT + slot * DEXP + c))) vfail(ctl, l * 8 + 6);
    } else if (s == 5) {
        const int ks = (int)((hs >> 5) & 1u), n = (int)((hs >> 7) % (unsigned)D);
        const v4u a4 = ((const v4u*)ti)[2 * t]; const int e = (ks ? (int)a4.y : (int)a4.x) & 31, r = ks ? (int)a4.w : (int)a4.z;
        const size_t slot = (size_t)((const LAS int*)(lds + TB_OFF))[e] * 256 + r;
        float a = 0.f; for (int c = 0; c < DEXP; ++c) a += bfld(ACT + slot * DEXP + c) * bfr(P.wd[((size_t)e * DEXP + c) * D + n]);
        if (vbad(a, bfld(YS + slot * D + n))) vfail(ctl, l * 8 + 7);
    }
    (void)cntw;
}
#endif
#ifndef MK_DUP
#define MK_DUP 0
#endif
#ifndef MK_DRY
#define MK_DRY 0
#endif
#ifndef MK_NOLOAD
#define MK_NOLOAD 0
#endif
#ifndef MK_DUPL
#define MK_DUPL 15
#endif
#ifndef MK_DUPC
#define MK_DUPC 1
#endif
#ifndef MK_MFMA_KINDS
#define MK_MFMA_KINDS 7
#endif
#ifndef PH_MASK
#define PH_MASK 0xff
#endif
#define PH_ON(k) (((PH_MASK) >> (k)) & 1)
#ifndef CV_KA
#define CV_KA 10
#endif
#ifndef CV_KB
#define CV_KB 2
#endif
#define CV_SETUP() do { if (l + 1 < NLAYER) { const int nwg_ = 4 * __builtin_amdgcn_readfirstlane(((const LAS int*)(lds + TB_OFF))[32]); cv_rem = nwg_ % G; cv_nidle = cv_rem ? G - cv_rem : 0; cv_idle = cv_rem != 0 && bx >= cv_rem; \
        const int nit_ = convert_nitems(nqkv_n); cv_na = cv_nidle * NWAVES * CV_KA; if (cv_na > nit_) cv_na = nit_; cv_nb = cv_nidle * NWAVES * CV_KB; if (cv_nb > nit_ - cv_na) cv_nb = nit_ - cv_na; } } while (0)
__global__ void __launch_bounds__(NWAVES * 64, 2) mk_fwd(Args args) {
    extern __shared__ __attribute__((aligned(16))) unsigned char lds_raw[];
    LAS unsigned char* lds = (LAS unsigned char*)lds_raw;
    volatile LAS unsigned* MISC = (volatile LAS unsigned*)(lds + MISC_OFF);
    for (int u = threadIdx.x; u < (LDS_BYTES - LDSCTL_OFF) / 4; u += NWAVES * 64) ((LAS unsigned*)(lds + LDSCTL_OFF))[u] = 0u;
    __syncthreads();
    const int lo = args.ph_lo, hi = args.ph_hi;
    XcdBarrier bar; bar.bar = (unsigned*)(args.ws + WS_CTL) + CW_BAR; bar.x = 0; bar.st = nullptr;
    if (hi - lo > 1) bar = xcd_barrier_post((unsigned*)(args.ws + WS_CTL) + CW_BAR + args.li * XCD_BAR_WORDS, MISC + 8);

    int dup_done = 0; (void)dup_done;
    for (int ph = lo; ph < hi; ++ph) {
        int tid = threadIdx.x; asm volatile("" : "+v"(tid));
        unsigned zoff = 0u; asm volatile("" : "+s"(zoff));
        unsigned char* ws = args.ws + zoff;
        int G = gridDim.x, bx = blockIdx.x; asm volatile("" : "+s"(G), "+s"(bx));
        const int lane = tid & 63, wave = __builtin_amdgcn_readfirstlane(tid >> 6);
        const int vcu = (G % 8 == 0) ? (bx % 8) * (G / 8) + bx / 8 : bx;
        const int gw = vcu * NWAVES + wave, NGW = G * NWAVES;
        unsigned* ctl = (unsigned*)(ws + WS_CTL);
        float* biasT = (float*)(ws + WS_BIAS);
        bf16* HB = (bf16*)(ws + WS_HB); bf16* QB = (bf16*)(ws + WS_Q); bf16* KB = (bf16*)(ws + WS_K); bf16* VB = (bf16*)(ws + WS_V); bf16* AO = (bf16*)(ws + WS_AO);
        bf16* YB = (bf16*)(ws + WS_Y); bf16* ACT = (bf16*)(ws + WS_ACT); bf16* YS = (bf16*)(ws + WS_YS);
        int* tok2 = (int*)(ws + WS_TOK2); unsigned* ti = (unsigned*)(ws + WS_TI);
        if (PH_ON(0) && ph == 0) {
            for (int i = bx * 512 + tid; i < 16 * 2049; i += G * 512) { const int h = i / 2049, rel = i % 2049 - 1024; biasT[i] = args.t5[t5_bucket(rel) * 16 + h]; }
            for (int i = bx * 512 + tid; i < 5 * 16 * AT_STRIDE; i += G * 512) { const int tb_ = i / (16 * AT_STRIDE), hh = (i / AT_STRIDE) % 16, j = i % AT_STRIDE; float v = -1e30f;
                if (tb_ == 0) { const int idx = j - 32; if (idx >= 0 && idx <= 256) v = args.t5[t5_bucket(idx - 128) * 16 + hh] * LOG2E; }
                else if (tb_ < 4) { const int dl_ = tb_ == 1 ? 16 : (tb_ == 2 ? 4 : 1), idx = j - 32; if (idx >= 0 && idx <= 128) v = args.t5[t5_bucket(dl_ * (idx - 64)) * 16 + hh] * LOG2E; }
                else { const int idx = j - 16; if (idx >= 0 && idx < 465) v = args.L[2].extra[hh * 465 + idx] * LOG2E; }
                ((float*)(ws + WS_BIAS + 256 * 1024))[i] = v; }
            for (size_t i = (size_t)bx * 512 + tid; i < (size_t)M * D / 8; i += (size_t)G * 512) { const f32x4 a = ((const f32x4*)args.x)[2 * i], b = ((const f32x4*)args.x)[2 * i + 1];
                v4u w; w.x = pkh(a.x, a.y); w.y = pkh(a.z, a.w); w.z = pkh(b.x, b.y); w.w = pkh(b.z, b.w); ((v4u*)HB)[i] = w; }
            for (int rc = 0; rc < MK_DUPC; ++rc) convert_layer_weights(args.L[0], 1536, ws, lds, gw, NGW, 0, convert_nitems(1536), wave, lane);
        } else {
            const int l = (ph - 1) / 7, s = (ph - 1) % 7, kind = (l == 1) ? 1 : (l == 2) ? 2 : 0;
            const int kvw = kind == 0 ? 256 : 1024, nqkv = 1024 + 2 * kvw;
            const LayerP& P = args.L[l];
            unsigned* cntw = ctl + CW_CNT + l * 32 * 32;
            const size_t wofs = (l & 1) ? WSET2_OFF : 0, wofs_n = (l & 1) ? 0 : WSET2_OFF;
            const int nqkv_n = (l + 1 == 1 || l + 1 == 2) ? 3072 : 1536;
            int cv_rem = 0, cv_nidle = 0, cv_na = 0, cv_nb = 0; bool cv_idle = false;
            if (PH_ON(1) && s == 0) {
                pg8::StaticOrder S; S.init(M / 256, nqkv / 256, G, bx);
                pg8::EpiQKV E{QB, KB, VB, kvw, 0.125f};
                pg8::gemm_phase<pg8::EpiQKV, pg8::StaticOrder, false, true, true>(tid, lds + RING_OFF, HB, (const bf16*)(ws + wofs + WS_WQKV), D, 0, nullptr, S, E);
            } else if (PH_ON(2) && s == 1) {
                bf16* OB = (bf16*)(ws + WS_OB); float* LSE = (float*)(ws + WS_LSE); const int sub = args.pad;
#if MK_DRYA
                if (kind == 0) attn_phase_mfma<0, 0, (MK_DRYA == 2)>(QB, KB, VB, biasT, P.extra, (bf16*)(ws + 720 * MiB), OB, LSE, 0, 1, lds, gw, NGW, wave, lane);
#endif
                if (kind == 0) { if (MK_MFMA_KINDS & 1) attn_coop_phase<0, 0>(QB, KB, VB, biasT, P.extra, AO, OB, LSE, 0, 1, lds, tid, vcu, G, wave, lane); else attnA_naive(QB, KB, VB, P.extra, biasT, AO, gw, NGW, lane); }
                else if (kind == 2) { if (MK_MFMA_KINDS & 4) { if (MK_COOPC) attn_coopC_phase(QB, KB, VB, biasT, AO, lds, tid, vcu, G, wave, lane); else attn_phase_mfma<2, 0>(QB, KB, VB, biasT, P.extra, AO, OB, LSE, 0, 1, lds, gw, NGW, wave, lane); } else attnC_naive(QB, KB, VB, P.extra, AO, gw, NGW, lane); }
                else if (MK_MFMA_KINDS & 2) {
                    const int nol_ = (MK_NOLOAD && MK_DUP && !dup_done) ? 1 : 0;
                    if (sub != 2) { attn_coop_phase<1, 1>(QB, KB, VB, biasT, nullptr, AO, OB, LSE, 0, 16, lds, tid, vcu, G, wave, lane, nol_);
                                    attn_coop_phase<1, 1>(QB, KB, VB, biasT, nullptr, AO, OB, LSE, 1, 4, lds, tid, vcu, G, wave, lane, nol_); }
                    if (sub == 0) xcd_barrier(bar);
                    if (sub != 1) attn_coop_phase<1, 2>(QB, KB, VB, biasT, nullptr, AO, OB, LSE, 0, 1, lds, tid, vcu, G, wave, lane, nol_);
                } else attnB_naive(QB, KB, VB, biasT, AO, gw, NGW, lane);
            } else if (PH_ON(3) && s == 2) {
                pg8::StaticOrder S; S.init(M / 256, D / 256, G, bx);
                pg8::EpiPlain E{YB, D};
                pg8::gemm_phase<pg8::EpiPlain, pg8::StaticOrder, false, true>(tid, lds + RING_OFF, AO, (const bf16*)(ws + wofs + WS_WO), D, 0, nullptr, S, E);
            } else if (PH_ON(4) && s == 3) {
{ const bool dry = ((MK_DUP >> 3) & 1) && !dup_done;
                  ln1_router_phase(HB, YB, P, dry ? (bf16*)(ws + 848 * MiB) : HB, dry ? ctl + 32768 : cntw,
                                   dry ? (int*)(ws + 912 * MiB) : tok2, dry ? (unsigned*)(ws + 916 * MiB) : ti, lds, tid, vcu, G, lane, wave); }
            } else if (PH_ON(5) && s == 4) {
                build_moe_tables(cntw, lds, tid);
                CV_SETUP();
                pg8::MoeOrder S; S.tb = (const LAS int*)(lds + TB_OFF); S.cnt = (const LAS int*)(lds + CNT_OFF); S.te = (const LAS unsigned*)(lds + TE_OFF);
                S.so.init(__builtin_amdgcn_readfirstlane(S.tb[32]), 4, G, bx);
                pg8::EpiSilu E{ACT};
                pg8::gemm_phase<pg8::EpiSilu, pg8::MoeOrder, true, true, true>(tid, lds + RING_OFF, HB, (const bf16*)(ws + wofs + WS_W1), D, (size_t)D * D, tok2, S, E);
                if (l + 1 < NLAYER && cv_idle) convert_layer_weights(args.L[l + 1], nqkv_n, ws + wofs_n, lds, (bx - cv_rem) * NWAVES + wave, cv_nidle * NWAVES, 0, cv_na, wave, lane);
            } else if (PH_ON(6) && s == 5) {
                if (ph == lo || MK_DUP) build_moe_tables(cntw, lds, tid);
                CV_SETUP();
                pg8::MoeOrder S; S.tb = (const LAS int*)(lds + TB_OFF); S.cnt = (const LAS int*)(lds + CNT_OFF); S.te = (const LAS unsigned*)(lds + TE_OFF);
                S.so.init(__builtin_amdgcn_readfirstlane(S.tb[32]), 4, G, bx);
                pg8::EpiPlain E{YS, D};
                pg8::gemm_phase<pg8::EpiPlain, pg8::MoeOrder, false, true>(tid, lds + RING_OFF, ACT, (const bf16*)(ws + wofs + WS_W2), DEXP, (size_t)D * DEXP, nullptr, S, E);
                if (l + 1 < NLAYER && cv_idle) convert_layer_weights(args.L[l + 1], nqkv_n, ws + wofs_n, lds, (bx - cv_rem) * NWAVES + wave, cv_nidle * NWAVES, cv_na, cv_na + cv_nb, wave, lane);
            } else if (PH_ON(7)) {
                if (ph == lo || MK_DUP) build_moe_tables(cntw, lds, tid);
                CV_SETUP();
#if MK_DRY & 2
                ln2_combine_phase(HB, (float*)(ws + 720 * MiB), l == NLAYER - 1, YS, P, (bf16*)(ws + 848 * MiB), ti, lds, gw, NGW, lane);
#endif
                ln2_combine_phase(HB, args.out, l == NLAYER - 1, YS, P, HB, ti, lds, gw, NGW, lane);
                if (l + 1 < NLAYER) { __syncthreads(); for (int rc = 0; rc < MK_DUPC; ++rc) convert_layer_weights(args.L[l + 1], nqkv_n, ws + wofs_n, lds, gw, NGW, cv_na + cv_nb, convert_nitems(nqkv_n), wave, lane); }
            }
        }
        if (ph + 1 < hi) xcd_barrier(bar);
        if (MK_DUP) { if (ph > 0 && ((MK_DUP >> ((ph - 1) % 7)) & 1) && ((MK_DUPL >> ((ph - 1) / 7)) & 1) && !dup_done) { dup_done = 1; --ph; } else dup_done = 0; }
    }
}

#if MK_VERIFY
__global__ void __launch_bounds__(NWAVES * 64) mk_verify(Args args) {
    extern __shared__ __attribute__((aligned(16))) unsigned char lds_raw[];
    LAS unsigned char* lds = (LAS unsigned char*)lds_raw;
    const int ph = args.ph_lo;
    if (ph == 63) { if (blockIdx.x == 0 && threadIdx.x == 0) { int code = 0; for (int c = 63; c >= 1; --c) if (__hip_atomic_load((unsigned*)(args.ws + WS_CTL) + 64 + c, RLX_AGENT) > 1000u) code = c; if (code == 2) { const float F = (float)__hip_atomic_load((unsigned*)(args.ws + WS_CTL) + 128, RLX_AGENT); int e = 8;
            for (int q = 0; q < 3; ++q) { const float fr = (float)__hip_atomic_load((unsigned*)(args.ws + WS_CTL) + 129 + q, RLX_AGENT) / F; e += (fr < 0.15f ? 0 : (fr < 0.4f ? 1 : (fr < 0.6f ? 2 : 3))) << (2 * q); }
            args.out[0] = exp2f((float)e); }
        else if (code) args.out[0] = exp2f((float)(code + 2)); } return; }
    const int vp = ph - 64;
    if (vp > 0) { const int l_ = (vp - 1) / 7, s_ = (vp - 1) % 7; if (s_ >= 3) build_moe_tables((unsigned*)(args.ws + WS_CTL) + CW_CNT + l_ * 32 * 32, lds, (int)threadIdx.x); }
    verify_phase(args, vp, args.ws, lds, (int)threadIdx.x, (int)blockIdx.x);
}
#endif
extern "C" void kernel_launch(void* const* d_in, const int* in_sizes, int n_in, void* d_out, int out_size, void* d_ws, size_t ws_size, hipStream_t stream) {
    static int grid = 0;
    if (grid == 0) {
        if (n_in != 57 || in_sizes[0] != M * D || out_size != M * D || ws_size < ((MK_DRY || MK_DRYA) ? 920 * MiB : (WSET2_OFF + 106 * MiB) + (MK_VERIFY ? 144 * MiB : 0))) { fprintf(stderr, "kernel_launch: unexpected shapes (n_in %d, in0 %d, out %d, ws %zu); nothing launched\n", n_in, n_in > 0 ? in_sizes[0] : -1, out_size, ws_size); grid = -1; return; }
        int dev = 0, cus = 0, per_cu = 0;
        if (hipGetDevice(&dev) != hipSuccess || hipDeviceGetAttribute(&cus, hipDeviceAttributeMultiprocessorCount, dev) != hipSuccess) { grid = -1; return; }
#if MK_VERIFY
        (void)hipFuncSetAttribute((const void*)mk_verify, hipFuncAttributeMaxDynamicSharedMemorySize, LDS_BYTES);
#endif
        if (hipFuncSetAttribute((const void*)mk_fwd, hipFuncAttributeMaxDynamicSharedMemorySize, LDS_BYTES) != hipSuccess) { fprintf(stderr, "kernel_launch: hipFuncSetAttribute failed\n"); grid = -1; return; }
        if (hipOccupancyMaxActiveBlocksPerMultiprocessor(&per_cu, (const void*)mk_fwd, NWAVES * 64, LDS_BYTES) != hipSuccess || per_cu < 1) { fprintf(stderr, "kernel_launch: occupancy query says %d blocks/CU\n", per_cu); }
        (void)hipGetLastError();
        grid = cus;
    }
    if (grid < 0) return;
    (void)hipMemsetAsync((char*)d_ws + WS_CTL, 0, CTL_ZERO_BYTES, stream);
    Args a{};
    a.x = (const float*)d_in[0]; a.t5 = (const float*)d_in[1];
    int k = 2;
    for (int l = 0; l < NLAYER; ++l) {
        const int kind = (l == 1) ? 1 : (l == 2) ? 2 : 0; LayerP& P = a.L[l];
        P.wqkv = (const float*)d_in[k++];
        P.extra = (kind == 1) ? nullptr : (const float*)d_in[k++];
        P.wo = (const float*)d_in[k++]; P.ln1g = (const float*)d_in[k++]; P.ln1b = (const float*)d_in[k++];
        P.rgw = (const float*)d_in[k++]; P.rgb = (const float*)d_in[k++]; P.rew = (const float*)d_in[k++]; P.reb = (const float*)d_in[k++];
        P.wg = (const float*)d_in[k++]; P.wu = (const float*)d_in[k++]; P.wd = (const float*)d_in[k++]; P.ln2g = (const float*)d_in[k++]; P.ln2b = (const float*)d_in[k++];
    }
    a.out = (float*)d_out; a.ws = (unsigned char*)d_ws;
#if MK_VERIFY
    for (int ph = 0; ph <= NPHASE; ++ph) {
        if (ph < NPHASE) {
            const int s_ = ph ? (ph - 1) % 7 : -1, l_ = ph ? (ph - 1) / 7 : 0;
            if ((s_ == 3 && l_ > 0) || s_ == 6) (void)hipMemcpyAsync((char*)d_ws + WS_SNAP, d_out, (size_t)M * D * 4, hipMemcpyDeviceToDevice, stream);
            a.ph_lo = ph; a.ph_hi = ph + 1; a.li = 0;
            if (s_ == 1 && l_ == 1) { a.pad = 1; hipLaunchKernelGGL(mk_fwd, dim3(grid), dim3(NWAVES * 64), LDS_BYTES, stream, a); a.pad = 2; }
            hipLaunchKernelGGL(mk_fwd, dim3(grid), dim3(NWAVES * 64), LDS_BYTES, stream, a); a.pad = 0;
            a.ph_lo = 64 + ph; a.ph_hi = 65 + ph;
            hipLaunchKernelGGL(mk_verify, dim3(grid), dim3(NWAVES * 64), LDS_BYTES, stream, a);
        } else { a.ph_lo = 63; a.ph_hi = 64; hipLaunchKernelGGL(mk_verify, dim3(grid), dim3(NWAVES * 64), LDS_BYTES, stream, a); }
    }
#else
    constexpr int NL = MK_N_LAUNCHES;
    for (int li = 0; li < NL; ++li) {
        a.ph_lo = (NL == NPHASE) ? li : (li * NPHASE) / NL; a.ph_hi = (NL == NPHASE) ? li + 1 : ((li + 1) * NPHASE) / NL; a.li = li;
        hipLaunchKernelGGL(mk_fwd, dim3(grid), dim3(NWAVES * 64), LDS_BYTES, stream, a);
        const hipError_t le = hipPeekAtLastError();
        if (le != hipSuccess) { fprintf(stderr, "kernel_launch: launch %d failed: %s\n", li, hipGetErrorName(le)); break; }
    }
#endif
}
```

```cpp
#include <hip/hip_runtime.h>
#include <cstdio>
#include <cstdint>

#ifndef MK_N_LAUNCHES
#define MK_N_LAUNCHES 1
#endif

#ifndef MK_EARLY_ACQ
#define MK_EARLY_ACQ 1
#endif
#ifndef MK_COOPC
#define MK_COOPC 1
#endif
#ifndef MK_DRYA
#define MK_DRYA 0
#endif
#define LAS __attribute__((address_space(3)))
#define GAS __attribute__((address_space(1)))
typedef unsigned short bf16;
typedef unsigned v4u __attribute__((ext_vector_type(4)));
typedef unsigned v2u __attribute__((ext_vector_type(2)));
typedef float f32x4 __attribute__((ext_vector_type(4)));
typedef float f32x2 __attribute__((ext_vector_type(2)));
typedef short bf16x8 __attribute__((ext_vector_type(8)));

constexpr int BATCH = 8, SEQ = 4096, D = 1024, H = 16, HD = 64, M = BATCH * SEQ;
constexpr int NEXP = 32, DEXP = 512, NLAYER = 4;
constexpr float LN_EPS = 1e-5f;
constexpr float ALPHA = 1.681792830507429f;
constexpr int NWAVES = 8;
constexpr int NPHASE = 1 + 7 * NLAYER;

constexpr size_t MiB = 1u << 20;
constexpr size_t WS_CTL = 0, CTL_ZERO_BYTES = 160 * 1024;
constexpr size_t WS_BIAS = 1 * MiB;
constexpr size_t WS_WQKV = 392 * MiB, WS_WO = 398 * MiB, WS_W1 = 400 * MiB, WS_W2 = 464 * MiB;
constexpr size_t WSET2_OFF = 104 * MiB;
constexpr size_t WS_HB = 600 * MiB;
constexpr size_t WS_TOK2 = 664 * MiB;
constexpr size_t WS_TI = 668 * MiB;
constexpr size_t WS_Q = 2 * MiB, WS_K = 66 * MiB, WS_V = 130 * MiB, WS_AO = 194 * MiB;
constexpr size_t WS_Y = WS_Q;
constexpr size_t WS_ACT = 2 * MiB;
constexpr size_t WS_YS = 74 * MiB;
constexpr size_t WS_END = 258 * MiB;
constexpr int CW_TMO = 0, CW_CODE = 1, CW_BAR = 4096, CW_CNT = 16384;

constexpr int RING_OFF = 0, RING_BYTES = 131072;
constexpr int VO_OFF = RING_BYTES;
constexpr int LDSCTL_OFF = VO_OFF + 16384;
constexpr int MISC_OFF = LDSCTL_OFF + 320;
constexpr int TB_OFF = MISC_OFF + 128;
constexpr int CNT_OFF = TB_OFF + 160;
constexpr int TE_OFF = CNT_OFF + 128;
constexpr int TABB_OFF = LDSCTL_OFF + 2048;
constexpr int MRG_OFF = TABB_OFF + 2048;
constexpr int LDS_BYTES = 153600;
static_assert(TE_OFF + 1280 <= TABB_OFF && MRG_OFF + 2048 <= LDS_BYTES, "LDS map");

#define RLX_AGENT __ATOMIC_RELAXED, __HIP_MEMORY_SCOPE_AGENT
#define LDS_WAIT() asm volatile("s_waitcnt lgkmcnt(0)" ::: "memory")
#define VM_WAIT() asm volatile("s_waitcnt vmcnt(0)" ::: "memory")
__device__ __forceinline__ unsigned f2bf(float f) { unsigned u = __builtin_bit_cast(unsigned, f); return (u + 0x7fffu + ((u >> 16) & 1u)) >> 16; }
__device__ __forceinline__ unsigned pk2(float lo, float hi) { return f2bf(lo) | (f2bf(hi) << 16); }
__device__ __forceinline__ float bflo(unsigned w) { return __builtin_bit_cast(float, w << 16); }
__device__ __forceinline__ float bfhi(unsigned w) { return __builtin_bit_cast(float, w & 0xffff0000u); }
typedef _Float16 f16x8 __attribute__((ext_vector_type(8)));
typedef _Float16 f16x2 __attribute__((ext_vector_type(2)));
__device__ __forceinline__ unsigned pkh(float lo, float hi) { f16x2 h; h.x = (_Float16)lo; h.y = (_Float16)hi; return __builtin_bit_cast(unsigned, h); }
__device__ __forceinline__ float hlo(unsigned w) { const unsigned short s = (unsigned short)(w & 0xffffu); return (float)__builtin_bit_cast(_Float16, s); }
__device__ __forceinline__ float hhi(unsigned w) { const unsigned short s = (unsigned short)(w >> 16); return (float)__builtin_bit_cast(_Float16, s); }
#define DPP_ADD(v, ctrl) ((v) + __builtin_bit_cast(float, __builtin_amdgcn_update_dpp(0, __builtin_bit_cast(int, (v)), (ctrl), 0xF, 0xF, true)))
__device__ __forceinline__ float wave_sum(float v) {
    v = DPP_ADD(v, 0xB1); v = DPP_ADD(v, 0x4E); v = DPP_ADD(v, 0x141); v = DPP_ADD(v, 0x140);
    const int b = __builtin_bit_cast(int, v);
    const float r0 = __builtin_bit_cast(float, __builtin_amdgcn_readlane(b, 0)), r1 = __builtin_bit_cast(float, __builtin_amdgcn_readlane(b, 16));
    const float r2 = __builtin_bit_cast(float, __builtin_amdgcn_readlane(b, 32)), r3 = __builtin_bit_cast(float, __builtin_amdgcn_readlane(b, 48));
    return (r0 + r1) + (r2 + r3);
}
__device__ __forceinline__ float xor32_max(float v) { const auto rr = __builtin_amdgcn_permlane32_swap(__builtin_bit_cast(unsigned, v), __builtin_bit_cast(unsigned, v), false, false);
    const unsigned a0 = rr[0], a1 = rr[1]; return fmaxf(__builtin_bit_cast(float, a0), __builtin_bit_cast(float, a1)); }
__device__ __forceinline__ float xor32_sum(float v) { const auto rr = __builtin_amdgcn_permlane32_swap(__builtin_bit_cast(unsigned, v), __builtin_bit_cast(unsigned, v), false, false);
    const unsigned a0 = rr[0], a1 = rr[1]; return __builtin_bit_cast(float, a0) + __builtin_bit_cast(float, a1); }
__device__ __forceinline__ int t5_bucket(int rel) {
    const int n = rel < 0 ? -rel : rel;
    int b = n < 8 ? n : 8 + (n >= 15) + (n >= 27) + (n >= 50) + (n >= 91) + (n >= 166) + (n >= 305) + (n >= 559);
    return b + (rel > 0 ? 16 : 0);
}

namespace pg8 {
typedef unsigned short bf16_t;
typedef unsigned u32x4 __attribute__((ext_vector_type(4)));
constexpr int BM = 256, BK = 64, HALF = 128, HTB = HALF * BK * 2, STAGE_BYTES = 8 * HTB, NXCD = 8, WGM = 8;
__host__ __device__ __forceinline__ int lds_byte(int r, int c) { const int st = (r >> 4) * 2 + (c >> 5), rr = r & 15, cc = c & 31, ob = rr * 64 + cc * 2; return st * 1024 + (ob ^ (((ob >> 9) & 1) << 5)); }
__host__ __device__ __forceinline__ void stage_rc(int b, int& R, int& C) { const int st = b / 1024, sb = b % 1024, swz = sb ^ (((sb >> 9) & 1) << 5); R = (st >> 1) * 16 + swz / 64; C = (st & 1) * 32 + (swz % 64) / 2; }
__host__ __device__ __forceinline__ int perm32(int rho) { const int n = rho >> 4, i = rho & 15; return 8 * (i >> 2) + 4 * n + (i & 3); }

struct Unit { int pm, pn, e, r0, nv; };

struct StaticOrder {
    int nM, nN, nwg, G, c;
    __device__ __forceinline__ void init(int nM_, int nN_, int G_, int c_) { nM = nM_; nN = nN_; nwg = nM * nN; G = G_; c = c_; }
    __device__ __forceinline__ bool next(int i, Unit& u) const {
        const long L = (long)i * G + c; if (L >= nwg) return false;
        int wgid = (int)L; { const int q = nwg / NXCD, r = nwg % NXCD, xcd = wgid % NXCD, off = wgid / NXCD; wgid = (xcd < r ? xcd * (q + 1) : r * (q + 1) + (xcd - r) * q) + off; }
        const int nig = WGM * nN, gid = wgid / nig, fm = gid * WGM, gsz = (nM - fm) < WGM ? (nM - fm) : WGM, wi = wgid - gid * nig;
        if (gsz == WGM) { u.pm = fm + (wi & (WGM - 1)); u.pn = wi / WGM; }
        else { u.pm = fm + (wi % gsz); u.pn = wi / gsz; } u.e = 0; u.r0 = 0; u.nv = 256; return true;
    }
};
struct MoeOrder {
    StaticOrder so; const LAS int* tb; const LAS int* cnt; const LAS unsigned* te;
    __device__ __forceinline__ bool next(int i, Unit& u) const {
        if (!so.next(i, u)) return false;
        const unsigned w = (unsigned)__builtin_amdgcn_readfirstlane((int)te[u.pm]);
        u.e = (int)(w & 31u); u.r0 = (int)(w >> 20) * 256; u.nv = (int)((w >> 8) & 0xfffu); return true;
    }
};

__device__ __forceinline__ unsigned cvt_pk_bf16(float lo, float hi) { unsigned r; asm volatile("v_cvt_pk_bf16_f32 %0, %1, %2" : "=v"(r) : "v"(lo), "v"(hi)); return r; }

constexpr int M_TOK = 32768;
struct EpiQKV {
    static constexpr bool PERM = true;
    bf16_t *Q, *K, *V; int kvw; float qscale;
    __device__ __forceinline__ void operator()(const f32x4 (&acc)[2][2][4][2], const Unit& u, int wr, int wc, int fr, int fq) const {
        const int row0 = u.pm * BM + wr * 64 + fr; int colt = u.pn * BM; bf16_t* base; int ldc; float sc = 1.f;
        if (colt < 1024) { base = Q; ldc = 1024; sc = qscale; } else if (colt < 1024 + kvw) { base = K; ldc = kvw; colt -= 1024; } else { base = V; ldc = kvw; colt -= 1024 + kvw; }
        (void)ldc;
        const int col0 = colt + wc * 32 + 8 * fq;
#pragma unroll
        for (int ai = 0; ai < 2; ++ai)
#pragma unroll
            for (int m = 0; m < 4; ++m) { const size_t row = (size_t)(row0 + ai * HALF + m * 16);
#pragma unroll
                for (int bj = 0; bj < 2; ++bj) { const f32x4 v0 = acc[ai][bj][m][0] * sc, v1 = acc[ai][bj][m][1] * sc; const int c = col0 + bj * HALF;
                    u32x4 w; w.x = cvt_pk_bf16(v0[0], v0[1]); w.y = cvt_pk_bf16(v0[2], v0[3]); w.z = cvt_pk_bf16(v1[0], v1[1]); w.w = cvt_pk_bf16(v1[2], v1[3]);
                    *(u32x4*)(base + ((size_t)(c >> 6) * M_TOK + row) * 64 + (c & 63)) = w; } }
    }
};
struct EpiPlain {
    static constexpr bool PERM = true;
    bf16_t* O; int ldc;
    __device__ __forceinline__ void operator()(const f32x4 (&acc)[2][2][4][2], const Unit& u, int wr, int wc, int fr, int fq) const {
        const int row0 = u.pm * BM + wr * 64 + fr; const int col0 = u.pn * BM + wc * 32 + 8 * fq;
#pragma unroll
        for (int ai = 0; ai < 2; ++ai)
#pragma unroll
            for (int m = 0; m < 4; ++m) { bf16_t* rowp = O + (size_t)(row0 + ai * HALF + m * 16) * ldc + col0;
#pragma unroll
                for (int bj = 0; bj < 2; ++bj) { const f32x4 v0 = acc[ai][bj][m][0], v1 = acc[ai][bj][m][1];
                    u32x4 w; w.x = cvt_pk_bf16(v0[0], v0[1]); w.y = cvt_pk_bf16(v0[2], v0[3]); w.z = cvt_pk_bf16(v1[0], v1[1]); w.w = cvt_pk_bf16(v1[2], v1[3]);
                    *(u32x4*)(rowp + bj * HALF) = w; } }
    }
};
__device__ __forceinline__ float silu_mul(float g, float u) { return g * u * __builtin_amdgcn_rcpf(1.0f + __builtin_amdgcn_exp2f(-1.4426950408889634f * g)); }
constexpr int ACT_SLOTS = 73728;
struct EpiSilu {
    static constexpr bool PERM = true;
    bf16_t* O;
    __device__ __forceinline__ void operator()(const f32x4 (&acc)[2][2][4][2], const Unit& u, int wr, int wc, int fr, int fq) const {
        const int row0 = u.pm * BM + wr * 64 + fr; const int col0 = u.pn * HALF + wc * 32 + 8 * fq;
#pragma unroll
        for (int ai = 0; ai < 2; ++ai)
#pragma unroll
            for (int m = 0; m < 4; ++m) { bf16_t* rowp = O + ((size_t)(col0 >> 6) * ACT_SLOTS + (size_t)(row0 + ai * HALF + m * 16)) * 64 + (col0 & 63);
                const f32x4 g0 = acc[ai][0][m][0], g1 = acc[ai][0][m][1], u0 = acc[ai][1][m][0], u1 = acc[ai][1][m][1];
                u32x4 w; w.x = cvt_pk_bf16(silu_mul(g0[0], u0[0]), silu_mul(g0[1], u0[1])); w.y = cvt_pk_bf16(silu_mul(g0[2], u0[2]), silu_mul(g0[3], u0[3]));
                w.z = cvt_pk_bf16(silu_mul(g1[0], u1[0]), silu_mul(g1[1], u1[1])); w.w = cvt_pk_bf16(silu_mul(g1[2], u1[2]), silu_mul(g1[3], u1[3]));
                *(u32x4*)rowp = w; }
    }
};

template <class Epi, class Sched, bool GATHER, bool ALIGN_EPI, bool F16 = false, int AKT = 0>
__device__ __forceinline__ void gemm_phase(const int tid, LAS unsigned char* lds, const bf16_t* A, const bf16_t* Bt, const int K, const size_t estride, const int* toks, const Sched& S, const Epi& E) {
    const int wid = __builtin_amdgcn_readfirstlane(tid >> 6), lane = tid & 63, wr = wid >> 2, wc = wid & 3, fr = lane & 15, fq = lane >> 4;
    const int nt = K / BK;
    unsigned voffA[2], voffB[2];
#pragma unroll
    for (int i = 0; i < 2; ++i) { int R, C; stage_rc(tid * 16 + i * 8192, R, C); const int Rb = Epi::PERM ? ((R & ~31) + perm32(R & 31)) : R; voffA[i] = (unsigned)(R * (AKT ? BK : K) + C) * 2u; voffB[i] = (unsigned)(Rb * K + C) * 2u; }
    const size_t kstep = (size_t)(BK * 2);
    const size_t hstep = (size_t)HALF * K * 2;
    const size_t tstep = 2 * hstep;
    const size_t kstepA = AKT ? (size_t)AKT * BK * 2 : kstep, hstepA = AKT ? (size_t)HALF * BK * 2 : hstep, tstepA = 2 * hstepA;
    const unsigned ldsw = (unsigned)wid * 1024u;
    const int aoff = lds_byte(wr * 64 + fr, fq * 8), boff = lds_byte(wc * 32 + fr, fq * 8);
#define PG8_SA(b, h) (((b) * 2 + (h)) * HTB)
#define PG8_SB(b, h) ((4 + (b) * 2 + (h)) * HTB)
#define PG8_STAGE2(bufoff, gbase, v0, v1) do { \
        __builtin_amdgcn_global_load_lds((const unsigned*)((const char*)(gbase) + (v0)), (LAS unsigned*)(lds + (bufoff) + ldsw), 16, 0, 0); \
        __builtin_amdgcn_global_load_lds((const unsigned*)((const char*)(gbase) + (v1)), (LAS unsigned*)(lds + (bufoff) + ldsw + 8192), 16, 0, 0); } while (0)
#define PG8_STAGE_B(bufoff, gbase) PG8_STAGE2(bufoff, gbase, voffB[0], voffB[1])
#define PG8_STAGE_A(bufoff, gbase, set, h) do { if constexpr (GATHER) { const v2u vo_ = *(const LAS v2u*)(vol + (set) * 8192 + (h) * 8); PG8_STAGE2(bufoff, gbase, vo_.x, vo_.y); } else { PG8_STAGE2(bufoff, (gbase) + (h) * hstepA, voffA[0], voffA[1]); } } while (0)
#define PG8_LDA(dst, b, h) do { _Pragma("unroll") for (int m = 0; m < 4; ++m) _Pragma("unroll") for (int k = 0; k < 2; ++k) dst[m][k] = *(const LAS bf16x8*)(lds + PG8_SA(b, h) + aoff + m * 2048 + k * 1024); } while (0)
#define PG8_LDB(dst, b, h) do { _Pragma("unroll") for (int n = 0; n < 2; ++n) _Pragma("unroll") for (int k = 0; k < 2; ++k) dst[n][k] = *(const LAS bf16x8*)(lds + PG8_SB(b, h) + boff + n * 2048 + k * 1024); } while (0)
#define PG8_MMA(ai, bj, At, Bt_) do { __builtin_amdgcn_s_setprio(1); _Pragma("unroll") for (int m = 0; m < 4; ++m) _Pragma("unroll") for (int n = 0; n < 2; ++n) _Pragma("unroll") for (int k = 0; k < 2; ++k) \
        { if constexpr (F16) acc[ai][bj][m][n] = __builtin_amdgcn_mfma_f32_16x16x32_f16(__builtin_bit_cast(f16x8, Bt_[n][k]), __builtin_bit_cast(f16x8, At[m][k]), acc[ai][bj][m][n], 0, 0, 0); \
          else acc[ai][bj][m][n] = __builtin_amdgcn_mfma_f32_16x16x32_bf16(Bt_[n][k], At[m][k], acc[ai][bj][m][n], 0, 0, 0); } __builtin_amdgcn_s_setprio(0); } while (0)
#define PG8_WAIT_V(n) asm volatile("s_waitcnt vmcnt(" #n ")" ::: "memory")
#define PG8_WAIT_L(n) asm volatile("s_waitcnt lgkmcnt(" #n ")" ::: "memory")
#define PG8_BAR __builtin_amdgcn_s_barrier()
#define PG8_SCHED __builtin_amdgcn_sched_barrier(0)
#define PG8_MKVO(u, set) do { if constexpr (GATHER) { int tk_[2][2]; const int* tp_ = toks + (size_t)(u).e * 32768 + (u).r0;        \
        _Pragma("unroll") for (int h_ = 0; h_ < 2; ++h_) _Pragma("unroll") for (int i_ = 0; i_ < 2; ++i_) { int R_, C_; stage_rc(tid * 16 + i_ * 8192, R_, C_); const int rl_ = h_ * HALF + R_; tk_[h_][i_] = tp_[rl_ < (u).nv ? rl_ : 0]; } \
        _Pragma("unroll") for (int h_ = 0; h_ < 2; ++h_) _Pragma("unroll") for (int i_ = 0; i_ < 2; ++i_) { int R_, C_; stage_rc(tid * 16 + i_ * 8192, R_, C_); const int rl_ = h_ * HALF + R_; const int tok_ = rl_ < (u).nv ? tk_[h_][i_] : 0; \
        *(LAS unsigned*)(vol + (set) * 8192 + h_ * 8 + i_ * 4) = (unsigned)tok_ * (unsigned)(K * 2) + (unsigned)(C_ * 2); } } } while (0)
#define PG8_BASEA(u) (GATHER ? (const char*)A : (const char*)A + (size_t)(u).pm * tstepA)
#define PG8_BASEB(u) ((const char*)Bt + ((size_t)(u).e * estride) * 2 + (size_t)(u).pn * tstep)
    Unit cur, nxt; int ui = 0;
    if (!S.next(0, cur)) return;
    f32x4 acc[2][2][4][2];
#pragma unroll
    for (int a = 0; a < 2; ++a)
#pragma unroll
        for (int b = 0; b < 2; ++b)
#pragma unroll
            for (int m = 0; m < 4; ++m)
#pragma unroll
                for (int n = 0; n < 2; ++n) acc[a][b][m][n] = (f32x4){0.f, 0.f, 0.f, 0.f};
    bf16x8 At[4][2], B0[2][2], B1[2][2];
    LAS unsigned char* vol = lds + VO_OFF + tid * 16;
    int cs = 0;
    PG8_MKVO(cur, 0);
    const char* cA = PG8_BASEA(cur); const char* cB = PG8_BASEB(cur);
    PG8_STAGE_B(PG8_SB(0, 0), cB); PG8_STAGE_B(PG8_SB(0, 1), cB + hstep); PG8_STAGE_A(PG8_SA(0, 0), cA, 0, 0); PG8_STAGE_A(PG8_SA(0, 1), cA, 0, 1);
    if (wr == 1) PG8_BAR;
    PG8_WAIT_V(2); PG8_BAR;
    PG8_STAGE_B(PG8_SB(1, 0), cB + kstep); PG8_STAGE_A(PG8_SA(1, 0), cA + kstepA, 0, 0); PG8_STAGE_B(PG8_SB(1, 1), cB + hstep + kstep);
    PG8_WAIT_V(6); PG8_BAR;
    for (;;) {
        const bool has_next = S.next(ui + 1, nxt);
        const char* nA = cA; const char* nB = cB;
        int ns = cs;
        if (has_next) { nA = PG8_BASEA(nxt); nB = PG8_BASEB(nxt); ns = cs ^ 1; PG8_MKVO(nxt, ns); }
        for (int t = 0; t < nt; t += 2) {
            const bool last = (t == nt - 2);
            const char* a1 = cA + (size_t)(t + 1) * kstepA;
            const char* a2 = last ? nA : cA + (size_t)(t + 2) * kstepA; const char* b2 = last ? nB : cB + (size_t)(t + 2) * kstep;
            const char* a3 = a2 + kstepA; const char* b3 = b2 + kstep;
            const int ss = last ? ns : cs;
            PG8_LDB(B0, 0, 0); PG8_LDB(B1, 0, 1); PG8_SCHED; PG8_LDA(At, 0, 0); PG8_STAGE_A(PG8_SA(1, 1), a1, cs, 1);
            PG8_WAIT_V(8); PG8_WAIT_L(0); PG8_BAR; PG8_MMA(0, 0, At, B0); PG8_MMA(0, 1, At, B1); PG8_BAR; PG8_SCHED;
            PG8_LDA(At, 0, 1); PG8_STAGE_B(PG8_SB(0, 0), b2); PG8_STAGE_B(PG8_SB(0, 1), b2 + hstep); PG8_STAGE_A(PG8_SA(0, 0), a2, ss, 0);
            PG8_WAIT_V(8); PG8_WAIT_L(0); PG8_BAR; PG8_MMA(1, 0, At, B0); PG8_MMA(1, 1, At, B1); PG8_BAR; PG8_SCHED;
            PG8_LDB(B0, 1, 0); PG8_LDB(B1, 1, 1); PG8_SCHED; PG8_LDA(At, 1, 0); PG8_STAGE_A(PG8_SA(0, 1), a2, ss, 1);
            PG8_WAIT_V(8); PG8_WAIT_L(0); PG8_BAR; PG8_MMA(0, 0, At, B0); PG8_MMA(0, 1, At, B1); PG8_BAR; PG8_SCHED;
            PG8_LDA(At, 1, 1); PG8_STAGE_B(PG8_SB(1, 0), b3); PG8_STAGE_B(PG8_SB(1, 1), b3 + hstep); PG8_STAGE_A(PG8_SA(1, 0), a3, ss, 0);
            PG8_WAIT_V(8); PG8_WAIT_L(0); PG8_BAR; PG8_MMA(1, 0, At, B0); PG8_MMA(1, 1, At, B1); PG8_BAR; PG8_SCHED;
        }
        if constexpr (ALIGN_EPI) { if (wr == 0) PG8_BAR; }
        E(acc, cur, wr, wc, fr, fq);
        if (!has_next) break;
#pragma unroll
        for (int a = 0; a < 2; ++a)
#pragma unroll
            for (int b = 0; b < 2; ++b)
#pragma unroll
                for (int m = 0; m < 4; ++m)
#pragma unroll
                    for (int n = 0; n < 2; ++n) acc[a][b][m][n] = (f32x4){0.f, 0.f, 0.f, 0.f};
        cur = nxt; cA = nA; cB = nB; ++ui; cs = ns;
        if constexpr (ALIGN_EPI) { if (wr == 1) PG8_BAR; }
    }
    PG8_WAIT_V(0);
    if constexpr (!ALIGN_EPI) { if (wr == 0) PG8_BAR; }
    PG8_BAR;
#undef PG8_SA
#undef PG8_SB
#undef PG8_STAGE2
#undef PG8_STAGE_A
#undef PG8_STAGE_B
#undef PG8_LDA
#undef PG8_LDB
#undef PG8_MMA
#undef PG8_WAIT_V
#undef PG8_WAIT_L
#undef PG8_BAR
#undef PG8_SCHED
#undef PG8_MKVO
#undef PG8_BASEA
#undef PG8_BASEB
}
}

#define XB_TMO      128
#define XB_XCNT(j)  (256  + 64 * (j))
#define XB_XSUB(j)  (1280 + 64 * (j))
#define XB_XGEN(j)  (2304 + 64 * (j))
#define XB_TOP      3328
#define XB_TOPGEN   3392
#define XCD_BAR_WORDS 3456
#define XB_SPIN_CAP (1u << 18)
__device__ __forceinline__ unsigned xb_ld(unsigned* p)              { return __hip_atomic_load(p, __ATOMIC_RELAXED, __HIP_MEMORY_SCOPE_AGENT); }
__device__ __forceinline__ unsigned xb_add(unsigned* p, unsigned v) { return __hip_atomic_fetch_add(p, v, __ATOMIC_RELAXED, __HIP_MEMORY_SCOPE_AGENT); }
__device__ __forceinline__ unsigned xb_xcc_id() { return (unsigned)__builtin_amdgcn_s_getreg((3 << 11) | 20) & 0xFu; }
#define XB_SPIN(cond, bar) do { unsigned _sp = 0; while (cond) { __builtin_amdgcn_s_sleep(1); \
    if ((++_sp & 255u) == 0u) { if (xb_ld(&(bar)[XB_TMO])) break; if (_sp > XB_SPIN_CAP) { atomicAdd(&(bar)[XB_TMO], 1u); break; } } } } while (0)
struct XcdBarrier { unsigned* bar; unsigned x; volatile LAS unsigned* st; };
__device__ __forceinline__ XcdBarrier xcd_barrier_post(unsigned* bar, volatile LAS unsigned* st) {
    XcdBarrier b; b.bar = bar; b.x = xb_xcc_id(); b.st = st;
    if (threadIdx.x == 0) (void)xb_add(&bar[XB_XCNT(b.x)], 1u);
    return b;
}
__device__ __forceinline__ void xcd_barrier_complete(unsigned* bar, unsigned x, unsigned& nloc, unsigned& nx) {
    const unsigned G = gridDim.x * gridDim.y * gridDim.z;
    unsigned sum, cnt, mine, sp = 0u;
    for (;;) {
        sum = 0u; cnt = 0u; mine = 0u;
#pragma unroll
        for (unsigned j = 0; j < 16; ++j) { const unsigned c = xb_ld(&bar[XB_XCNT(j)]); sum += c; cnt += (c > 0u) ? 1u : 0u; mine = (j == x) ? c : mine; }
        if (sum == G) break;
        __builtin_amdgcn_s_sleep(1);
        if ((++sp & 255u) == 0u) { if (xb_ld(&bar[XB_TMO])) break; if (sp > XB_SPIN_CAP) { atomicAdd(&bar[XB_TMO], 1u); break; } }
    }
    nloc = mine > 0u ? mine : 1u; nx = cnt > 0u ? cnt : 1u;
}
__device__ __forceinline__ void xcd_barrier(const XcdBarrier& b) {
    asm volatile("s_waitcnt vmcnt(0)" ::: "memory");
    __syncthreads();
    if (threadIdx.x == 0) {
        unsigned* bar = b.bar;
        __builtin_amdgcn_s_waitcnt(0);
#if MK_EARLY_ACQ
        __builtin_amdgcn_fence(__ATOMIC_ACQUIRE, "agent");
#endif
        unsigned nloc = b.st[0], nx = b.st[1];
        if (nloc == 0u) { xcd_barrier_complete(bar, b.x, nloc, nx); b.st[0] = nloc; b.st[1] = nx; }
        const unsigned old = xb_add(&bar[XB_XSUB(b.x)], 1u);
        const unsigned gen = old / nloc;
        if (old + 1u == (gen + 1u) * nloc) {
            __builtin_amdgcn_fence(__ATOMIC_RELEASE, "agent");
            asm volatile("s_waitcnt vmcnt(0)" ::: "memory");
            const unsigned og = xb_add(&bar[XB_TOP], 1u);
            const unsigned tg = og / nx;
            if (og + 1u == (tg + 1u) * nx) {
#pragma unroll
                for (unsigned j = 0; j < 16; ++j) __hip_atomic_fetch_add(&bar[XB_XGEN(j)], 1u, __ATOMIC_RELAXED, __HIP_MEMORY_SCOPE_AGENT);
            } else XB_SPIN(xb_ld(&bar[XB_XGEN(b.x)]) == gen, bar);
#if !MK_EARLY_ACQ
            __builtin_amdgcn_fence(__ATOMIC_ACQUIRE, "agent");
#endif
            asm volatile("s_waitcnt vmcnt(0)" ::: "memory");
        } else {
            XB_SPIN(xb_ld(&bar[XB_XGEN(b.x)]) == gen, bar);
#if !MK_EARLY_ACQ
            __builtin_amdgcn_fence(__ATOMIC_ACQUIRE, "agent");
#endif
            asm volatile("s_waitcnt vmcnt(0)" ::: "memory");
        }
    }
    __syncthreads();
}

struct LayerP { const float *wqkv, *extra, *wo, *ln1g, *ln1b, *rgw, *rgb, *rew, *reb, *wg, *wu, *wd, *ln2g, *ln2b; };
struct Args { const float* x; const float* t5; LayerP L[NLAYER]; float* out; unsigned char* ws; int ph_lo, ph_hi, li, pad; };

template <bool F16>
__device__ __forceinline__ void transpose_item(const float* W, int K, int N, bf16* WT, int ilv, LAS float* scrf, int item, int lane) {
    LAS unsigned* scr = (LAS unsigned*)scrf;
    const int nblk = N / 64, kb = item / nblk, nb = item % nblk, k0 = 64 * kb, n0 = 64 * nb;
    const int rbase = ilv ? ((n0 >> 7) * 256 + (n0 & 127) + (ilv == 2 ? 128 : 0)) : n0;
    const int kq = lane >> 4, nc = lane & 15;
    f32x4 w0[8], w1[8];
#pragma unroll
    for (int i = 0; i < 8; ++i) { const float* p = W + (size_t)(k0 + 8 * i + 2 * kq) * N + n0 + 4 * nc; w0[i] = __builtin_nontemporal_load((const f32x4*)p); w1[i] = __builtin_nontemporal_load((const f32x4*)(p + N)); }
#pragma unroll
    for (int i = 0; i < 8; ++i) { LAS unsigned* d = scr + (4 * nc) * 33 + 4 * i + kq;
        if constexpr (F16) { d[0] = pkh(w0[i].x, w1[i].x); d[33] = pkh(w0[i].y, w1[i].y); d[66] = pkh(w0[i].z, w1[i].z); d[99] = pkh(w0[i].w, w1[i].w); }
        else { d[0] = pk2(w0[i].x, w1[i].x); d[33] = pk2(w0[i].y, w1[i].y); d[66] = pk2(w0[i].z, w1[i].z); d[99] = pk2(w0[i].w, w1[i].w); } }
    LDS_WAIT(); asm volatile("" ::: "memory");
    const int c = lane & 7;
#pragma unroll
    for (int j = 0; j < 8; ++j) { const int n = (lane >> 3) + 8 * j; const LAS unsigned* sp = scr + n * 33 + 4 * c;
        v4u o; o.x = sp[0]; o.y = sp[1]; o.z = sp[2]; o.w = sp[3];
        *(v4u*)(WT + (size_t)(rbase + n) * K + k0 + 8 * c) = o; }
    LDS_WAIT(); asm volatile("" ::: "memory");
}
__device__ __forceinline__ int convert_nitems(int nqkv) { return (D / 64) * (nqkv / 64) + (D / 64) * (D / 64) + NEXP * (2 * (D / 64) * (DEXP / 64) + (DEXP / 64) * (D / 64)); }
__device__ __forceinline__ void convert_layer_weights(const LayerP& P, int nqkv, unsigned char* ws, LAS unsigned char* lds, int first, int step, int ibeg, int iend, int wave, int lane) {
    LAS float* scr = (LAS float*)(lds + RING_OFF + wave * 16384);
    bf16* Wqkv_t = (bf16*)(ws + WS_WQKV); bf16* Wo_t = (bf16*)(ws + WS_WO); bf16* W1_t = (bf16*)(ws + WS_W1); bf16* W2_t = (bf16*)(ws + WS_W2);
    const int I_QKV = (D / 64) * (nqkv / 64), I_O = (D / 64) * (D / 64), I_G = (D / 64) * (DEXP / 64), I_D = (DEXP / 64) * (D / 64);
    const int I_E = 2 * I_G + I_D;
    for (int it = ibeg + first; it < iend; it += step) {
        int r = it;
        if (r < I_QKV) { transpose_item<true>(P.wqkv, D, nqkv, Wqkv_t, 0, scr, r, lane); continue; } r -= I_QKV;
        if (r < I_O) { transpose_item<false>(P.wo, D, D, Wo_t, 0, scr, r, lane); continue; } r -= I_O;
        const int e = r / I_E; r -= e * I_E;
        if (r < I_G) { transpose_item<true>(P.wg + (size_t)e * D * DEXP, D, DEXP, W1_t + (size_t)e * D * D, 1, scr, r, lane); continue; } r -= I_G;
        if (r < I_G) { transpose_item<true>(P.wu + (size_t)e * D * DEXP, D, DEXP, W1_t + (size_t)e * D * D, 2, scr, r, lane); continue; } r -= I_G;
        transpose_item<false>(P.wd + (size_t)e * DEXP * D, DEXP, D, W2_t + (size_t)e * D * DEXP, 0, scr, r, lane);
    }
}

#define DOT8(s, qv, c, W4) do { s += qv[8 * (c) + 0] * bflo(W4[0]) + qv[8 * (c) + 1] * bfhi(W4[0]) + qv[8 * (c) + 2] * bflo(W4[1]) + qv[8 * (c) + 3] * bfhi(W4[1]) \
                                  + qv[8 * (c) + 4] * bflo(W4[2]) + qv[8 * (c) + 5] * bfhi(W4[2]) + qv[8 * (c) + 6] * bflo(W4[3]) + qv[8 * (c) + 7] * bfhi(W4[3]); } while (0)
#define AXPY8(ov, c, p, W4) do { ov[8 * (c) + 0] += p * bflo(W4[0]); ov[8 * (c) + 1] += p * bfhi(W4[0]); ov[8 * (c) + 2] += p * bflo(W4[1]); ov[8 * (c) + 3] += p * bfhi(W4[1]); \
                                 ov[8 * (c) + 4] += p * bflo(W4[2]); ov[8 * (c) + 5] += p * bfhi(W4[2]); ov[8 * (c) + 6] += p * bflo(W4[3]); ov[8 * (c) + 7] += p * bfhi(W4[3]); } while (0)
#define ATT_KEY(krow, vrow, biasv) do { \
        const v4u* kp_ = (const v4u*)(krow); float s_ = 0.f; \
        _Pragma("unroll") for (int c_ = 0; c_ < 8; ++c_) { const v4u w_ = kp_[c_]; DOT8(s_, q, c_, w_); } \
        s_ += (biasv); \
        if (s_ > m) { const float f_ = expf(m - s_); l *= f_; _Pragma("unroll") for (int d_ = 0; d_ < 64; ++d_) o[d_] *= f_; m = s_; } \
        const float p_ = expf(s_ - m); l += p_; \
        const v4u* vp_ = (const v4u*)(vrow); \
        _Pragma("unroll") for (int c_ = 0; c_ < 8; ++c_) { const v4u w_ = vp_[c_]; AXPY8(o, c_, p_, w_); } } while (0)
#define ATT_LOADQ(qrow) do { const v4u* qp_ = (const v4u*)(qrow); _Pragma("unroll") for (int c_ = 0; c_ < 8; ++c_) { const v4u w_ = qp_[c_]; \
        q[8 * c_ + 0] = bflo(w_.x); q[8 * c_ + 1] = bfhi(w_.x); q[8 * c_ + 2] = bflo(w_.y); q[8 * c_ + 3] = bfhi(w_.y); q[8 * c_ + 4] = bflo(w_.z); q[8 * c_ + 5] = bfhi(w_.z); q[8 * c_ + 6] = bflo(w_.w); q[8 * c_ + 7] = bfhi(w_.w); } \
        _Pragma("unroll") for (int d_ = 0; d_ < 64; ++d_) o[d_] = 0.f; } while (0)
#define ATT_STOREO(orow) do { const float rl_ = 1.0f / l; v4u* op_ = (v4u*)(orow); _Pragma("unroll") for (int c_ = 0; c_ < 8; ++c_) { v4u w_; \
        w_.x = pk2(o[8 * c_ + 0] * rl_, o[8 * c_ + 1] * rl_); w_.y = pk2(o[8 * c_ + 2] * rl_, o[8 * c_ + 3] * rl_); w_.z = pk2(o[8 * c_ + 4] * rl_, o[8 * c_ + 5] * rl_); w_.w = pk2(o[8 * c_ + 6] * rl_, o[8 * c_ + 7] * rl_); op_[c_] = w_; } } while (0)

__device__ __forceinline__ void attnA_naive(const bf16* Q, const bf16* Kb, const bf16* Vb, const float* sink, const float* biasT, bf16* AO, int gw, int NGW, int lane) {
    for (int wi = gw; wi < (M / 64) * H; wi += NGW) {
        const int h = wi & 15, t = (wi >> 4) * 64 + lane, b = t >> 12, pos = t & 4095, kvh = h >> 2;
        float q[64], o[64]; ATT_LOADQ(Q + (size_t)t * D + h * HD);
        float m = sink[h], l = 1.0f;
        const float* bh = biasT + h * 2049 + 1024;
        const int j0 = pos - 128 < 0 ? 0 : pos - 128, j1 = pos + 128 > SEQ - 1 ? SEQ - 1 : pos + 128;
        for (int j = j0; j <= j1; ++j) { const size_t kr = ((size_t)(b * SEQ + j)) * 256 + kvh * HD; ATT_KEY(Kb + kr, Vb + kr, bh[j - pos]); }
        ATT_STOREO(AO + (size_t)t * D + h * HD);
    }
}
__device__ __forceinline__ void attnB_naive(const bf16* Q, const bf16* Kb, const bf16* Vb, const float* biasT, bf16* AO, int gw, int NGW, int lane) {
    for (int wi = gw; wi < (M / 64) * H; wi += NGW) {
        const int h = wi & 15, t = (wi >> 4) * 64 + lane, b = t >> 12, pos = t & 4095;
        float q[64], o[64]; ATT_LOADQ(Q + (size_t)t * D + h * HD);
        float m = -1e30f, l = 0.0f;
        const float* bh = biasT + h * 2049 + 1024;
#pragma unroll 1
        for (int br = 0; br < 3; ++br) { const int dil = br == 0 ? 1 : br == 1 ? 4 : 16;
            for (int mm = -64; mm <= 64; ++mm) { const int j = pos + dil * mm; if (j < 0 || j >= SEQ) continue;
                const size_t kr = ((size_t)(b * SEQ + j)) * D + h * HD; ATT_KEY(Kb + kr, Vb + kr, bh[dil * mm]); } }
        ATT_STOREO(AO + (size_t)t * D + h * HD);
    }
}
__device__ __forceinline__ void attnC_naive(const bf16* Q, const bf16* Kb, const bf16* Vb, const float* rpb, bf16* AO, int gw, int NGW, int lane) {
    for (int wi = gw; wi < (M / 64) * H; wi += NGW) {
        const int h = wi & 15, t = (wi >> 4) * 64 + lane, b = t >> 12, pos = t & 4095, r = pos >> 6, c = pos & 63;
        float q[64], o[64]; ATT_LOADQ(Q + (size_t)t * D + h * HD);
        float m = -1e30f, l = 0.0f;
        const int rs = r - 4 < 0 ? 0 : (r - 4 > 56 ? 56 : r - 4), cs = c - 8 < 0 ? 0 : (c - 8 > 48 ? 48 : c - 8);
        const float* bh = rpb + h * (15 * 31);
#pragma unroll 1
        for (int rr = rs; rr < rs + 8; ++rr)
            for (int cc = cs; cc < cs + 16; ++cc) { int dc = cc - c; dc = dc < -15 ? -15 : (dc > 15 ? 15 : dc);
                const size_t kr = ((size_t)(b * SEQ + rr * 64 + cc)) * D + h * HD; ATT_KEY(Kb + kr, Vb + kr, bh[(rr - r + 7) * 31 + dc + 15]); }
        ATT_STOREO(AO + (size_t)t * D + h * HD);
    }
}


typedef float f32x16 __attribute__((ext_vector_type(16)));
typedef short v4i16 __attribute__((ext_vector_type(4)));
constexpr float LOG2E = 1.4426950408889634f;
constexpr int VT_ROWB = 192;
constexpr int AW_BYTES = 32 * VT_ROWB;
constexpr int AT_OFF = NWAVES * AW_BYTES, AT_STRIDE = 512;
constexpr size_t WS_OB = 258 * MiB;
constexpr size_t WS_LSE = 386 * MiB;
constexpr size_t WS_END2 = 390 * MiB;
__device__ __forceinline__ int crow(int i, int hi) { return (i & 3) + 8 * (i >> 2) + 4 * hi; }
__device__ __forceinline__ int iclamp(int x, int lo, int hi) { return x < lo ? lo : (x > hi ? hi : x); }

constexpr float ATT_THR = 8.0f;
__device__ __forceinline__ f32x16 att_qk(const bf16x8 (&Kf)[4], const bf16x8 (&Qf)[4]) {
    f32x16 S;
#pragma unroll
    for (int i = 0; i < 16; ++i) S[i] = 0.f;
#pragma unroll
    for (int st = 0; st < 4; ++st) S = __builtin_amdgcn_mfma_f32_32x32x16_bf16(Kf[st], Qf[st], S, 0, 0, 0);
    return S;
}
__device__ __forceinline__ void att_vread(v4i16 (&Vt)[8], LAS unsigned char* vt, const int lane) {
    const int i16 = lane & 15, g = lane >> 4;
    const LAS unsigned char* vb = vt + (4 * (g >> 1) + (i16 >> 2)) * VT_ROWB + (16 * (g & 1) + 4 * (i16 & 3)) * 2;
#pragma unroll
    for (int s2 = 0; s2 < 2; ++s2)
#pragma unroll
        for (int db = 0; db < 2; ++db) {
            Vt[(s2 * 2 + db) * 2 + 0] = __builtin_amdgcn_ds_read_tr16_b64_v4i16((LAS v4i16*)(vb + (16 * s2) * VT_ROWB + db * 64));
            Vt[(s2 * 2 + db) * 2 + 1] = __builtin_amdgcn_ds_read_tr16_b64_v4i16((LAS v4i16*)(vb + (16 * s2 + 8) * VT_ROWB + db * 64));
        }
}
__device__ __forceinline__ void att_soft_pv(f32x16& O0, f32x16& O1, float& m, float& l, const f32x16& S, const v4i16 (&Vt)[8], const float (&bs)[16], const int lane) {
    float a[16];
#pragma unroll
    for (int i = 0; i < 16; ++i) a[i] = fmaf(S[i], LOG2E, bs[i] - m);
    float mx = fmaxf(fmaxf(fmaxf(a[0], a[1]), fmaxf(a[2], a[3])), fmaxf(fmaxf(a[4], a[5]), fmaxf(a[6], a[7])));
    mx = fmaxf(mx, fmaxf(fmaxf(fmaxf(a[8], a[9]), fmaxf(a[10], a[11])), fmaxf(fmaxf(a[12], a[13]), fmaxf(a[14], a[15]))));
    mx = xor32_max(mx);
    if (__builtin_amdgcn_ballot_w64(mx > ATT_THR) != 0ull) {
        const float dl = mx > ATT_THR ? mx : 0.f, al = __builtin_amdgcn_exp2f(-dl);
        m += dl; l *= al;
#pragma unroll
        for (int i = 0; i < 16; ++i) { a[i] -= dl; O0[i] *= al; O1[i] *= al; }
    }
#pragma unroll
    for (int i = 0; i < 16; ++i) a[i] = __builtin_amdgcn_exp2f(a[i]);
    l += ((a[0] + a[1]) + (a[2] + a[3])) + ((a[4] + a[5]) + (a[6] + a[7])) + (((a[8] + a[9]) + (a[10] + a[11])) + ((a[12] + a[13]) + (a[14] + a[15])));
    bf16x8 Pf[2];
#pragma unroll
    for (int s2 = 0; s2 < 2; ++s2) { v4u w; w.x = pg8::cvt_pk_bf16(a[8 * s2 + 0], a[8 * s2 + 1]); w.y = pg8::cvt_pk_bf16(a[8 * s2 + 2], a[8 * s2 + 3]);
        w.z = pg8::cvt_pk_bf16(a[8 * s2 + 4], a[8 * s2 + 5]); w.w = pg8::cvt_pk_bf16(a[8 * s2 + 6], a[8 * s2 + 7]); Pf[s2] = __builtin_bit_cast(bf16x8, w); }
#pragma unroll
    for (int s2 = 0; s2 < 2; ++s2)
#pragma unroll
        for (int db = 0; db < 2; ++db) {
            const v4i16 lo = Vt[(s2 * 2 + db) * 2 + 0], hi4 = Vt[(s2 * 2 + db) * 2 + 1];
            const bf16x8 Vf = {lo[0], lo[1], lo[2], lo[3], hi4[0], hi4[1], hi4[2], hi4[3]};
            if (db == 0) O0 = __builtin_amdgcn_mfma_f32_32x32x16_bf16(Vf, Pf[s2], O0, 0, 0, 0);
            else O1 = __builtin_amdgcn_mfma_f32_32x32x16_bf16(Vf, Pf[s2], O1, 0, 0, 0);
        }
}

struct AttItem { int b, h, kh, q0, dil, res, L, R, c0, cb, rs0, tlo, thi; };
template <int KIND, int MODE, bool NOLOAD = false>
__device__ __forceinline__ void attn_item(const AttItem it, const bf16* Qb, const bf16* Kb, const bf16* Vb, const int kvld, const float* biasT, const float* extra,
                                          bf16* AO, bf16* OB, float* LSE, const int br, LAS unsigned char* wl, LAS float* tabs, const int lane) {
    const int r = lane & 31, hi = lane >> 5;
    LAS unsigned char* vt = wl; LAS float* tab = tabs + it.h * AT_STRIDE;
    int qpos;
    if constexpr (KIND == 0) qpos = it.q0 + r; else if constexpr (KIND == 1) qpos = it.res + it.dil * (it.q0 + r); else qpos = (it.R + (r >> 4)) * 64 + it.c0 + (r & 15);
    const size_t tq = (size_t)it.b * SEQ + qpos;
    bf16x8 Qf[4];
#pragma unroll
    for (int st = 0; st < 4; ++st) Qf[st] = *(const bf16x8*)(Qb + tq * D + it.h * HD + 16 * st + 8 * hi);
    float m = 0.f, l = 0.f;
    if constexpr (KIND == 0) { m = extra[it.h] * LOG2E; l = hi == 0 ? 1.0f : 0.0f; }
    f32x16 O0, O1;
#pragma unroll
    for (int i = 0; i < 16; ++i) { O0[i] = 0.f; O1[i] = 0.f; }
    const int step = KIND == 1 ? it.dil : 1;
    const long pos0 = KIND == 0 ? (long)it.b * SEQ + it.q0 - 128 : KIND == 1 ? (long)it.b * SEQ + it.res + (long)it.dil * (it.q0 - 64) : (long)it.b * SEQ + it.rs0 * 64 + it.cb;
    const long tinc = KIND == 0 ? 32 : KIND == 1 ? 32 * it.dil : 64;
    const unsigned rowB = (unsigned)kvld * 2u;
    const unsigned kOff = (unsigned)(r * step) * rowB + 16u * hi;
    unsigned vOff[4];
#pragma unroll
    for (int j = 0; j < 4; ++j) vOff[j] = (unsigned)(((lane >> 3) + 8 * j) * step) * rowB + (lane & 7) * 16u;
    const char* kbase = (const char*)Kb + (pos0 + it.tlo * tinc) * (long)rowB + it.kh * (HD * 2);
    const char* vbase = (const char*)Vb + (pos0 + it.tlo * tinc) * (long)rowB + it.kh * (HD * 2);
    const long tstepB = tinc * (long)rowB;
    int tb0, tbinc; float cneg[16];
    if constexpr (KIND == 2) {
        const int cq = it.c0 + (r & 15), csq = iclamp(cq - 8, 0, 48), w0 = csq - it.cb;
#pragma unroll
        for (int i = 0; i < 16; ++i) cneg[i] = ((unsigned)(crow(i, hi) - w0) < 16u) ? 0.f : -1e30f;
        tb0 = 4 * (16 + (it.cb - cq + 15) + 4 * hi); tbinc = 0;
    } else { tb0 = 4 * (32 + 4 * hi - r); tbinc = 128;
#pragma unroll
        for (int i = 0; i < 16; ++i) cneg[i] = 0.f; }
    bf16x8 Kfa[4], Kfb[4]; v4u Vn[4];
#define ATT_LOADK(K_, kb_) do { _Pragma("unroll") for (int st = 0; st < 4; ++st) K_[st] = *(const bf16x8*)((kb_) + kOff + 32 * st); } while (0)
#define ATT_LOADV(vb_) do { _Pragma("unroll") for (int j = 0; j < 4; ++j) Vn[j] = *(const v4u*)((vb_) + vOff[j]); } while (0)
    ATT_LOADK(Kfa, kbase); ATT_LOADV(vbase);
    if (it.tlo + 1 < it.thi) ATT_LOADK(Kfb, kbase + tstepB);
    f32x16 Sc = att_qk(Kfa, Qf);
#define ATT_STEP(t_, KU_, KL_) do { const int tt_ = (t_); \
        _Pragma("unroll") for (int j = 0; j < 4; ++j) *(LAS v4u*)(vt + ((lane >> 3) + 8 * j) * VT_ROWB + (lane & 7) * 16) = Vn[j]; \
        v4i16 Vt[8]; att_vread(Vt, vt, lane); __builtin_amdgcn_sched_barrier(0); \
        kbase += tstepB; vbase += tstepB; \
        if constexpr (!NOLOAD) { if (tt_ + 1 < it.thi) ATT_LOADV(vbase); if (tt_ + 2 < it.thi) ATT_LOADK(KL_, kbase + tstepB); } \
        f32x16 Sn = Sc; \
        if (tt_ + 1 < it.thi) Sn = att_qk(KU_, Qf);                      \
        float bs[16]; \
        if constexpr (KIND == 2) { \
            const int rq = it.R + (r >> 4), kr2 = it.rs0 + tt_, rsq = iclamp(rq - 4, 0, 56); \
            const float rneg = (kr2 >= rsq && kr2 < rsq + 8) ? 0.f : -1e30f; \
            const LAS float* tp = (const LAS float*)((const LAS unsigned char*)tab + tb0 + 4 * 31 * iclamp(kr2 - rq + 7, 0, 14)); \
            _Pragma("unroll") for (int i = 0; i < 16; ++i) bs[i] = tp[(i & 3) + 8 * (i >> 2)] + (cneg[i] + rneg); \
        } else { \
            const LAS float* tp = (const LAS float*)((const LAS unsigned char*)tab + tb0 + tt_ * tbinc); \
            _Pragma("unroll") for (int i = 0; i < 16; ++i) bs[i] = tp[(i & 3) + 8 * (i >> 2)]; \
        } \
        att_soft_pv(O0, O1, m, l, Sc, Vt, bs, lane); \
        Sc = Sn; } while (0)
    for (int t = it.tlo; t < it.thi; t += 2) { ATT_STEP(t, Kfb, Kfa); if (t + 1 < it.thi) ATT_STEP(t + 1, Kfa, Kfb); }
#undef ATT_STEP
#undef ATT_LOADK
#undef ATT_LOADV
    const float lt = xor32_sum(l);
    const float inv = 1.0f / lt;
    if constexpr (MODE == 2) {
        const float lse3 = m + __builtin_amdgcn_logf(lt);
        const float lse1 = LSE[tq * 16 + it.h], lse2 = LSE[(size_t)M * 16 + tq * 16 + it.h];
        const float mm = fmaxf(lse3, fmaxf(lse1, lse2)), w1 = __builtin_amdgcn_exp2f(lse1 - mm), w2 = __builtin_amdgcn_exp2f(lse2 - mm), w3 = __builtin_amdgcn_exp2f(lse3 - mm), wi = 1.0f / (w1 + w2 + w3);
        const float c1 = w1 * wi, c2 = w2 * wi, c3 = w3 * wi * inv;
#pragma unroll
        for (int db = 0; db < 2; ++db)
#pragma unroll
            for (int g4 = 0; g4 < 4; ++g4) { const size_t off = tq * D + it.h * HD + 32 * db + 8 * g4 + 4 * hi;
                const v2u a1 = *(const v2u*)(OB + off), a2 = *(const v2u*)(OB + (size_t)M * D + off);
                const f32x16& O = db == 0 ? O0 : O1;
                const float x0 = c3 * O[4 * g4 + 0] + c1 * bflo(a1.x) + c2 * bflo(a2.x), x1 = c3 * O[4 * g4 + 1] + c1 * bfhi(a1.x) + c2 * bfhi(a2.x);
                const float x2 = c3 * O[4 * g4 + 2] + c1 * bflo(a1.y) + c2 * bflo(a2.y), x3 = c3 * O[4 * g4 + 3] + c1 * bfhi(a1.y) + c2 * bfhi(a2.y);
                v2u w; w.x = pg8::cvt_pk_bf16(x0, x1); w.y = pg8::cvt_pk_bf16(x2, x3); *(v2u*)(AO + off) = w; }
    } else {
        bf16* dst = MODE == 1 ? OB + (size_t)br * M * D : AO;
#pragma unroll
        for (int db = 0; db < 2; ++db)
#pragma unroll
            for (int g4 = 0; g4 < 4; ++g4) { const size_t off = tq * D + it.h * HD + 32 * db + 8 * g4 + 4 * hi; const f32x16& O = db == 0 ? O0 : O1;
                v2u w; w.x = pg8::cvt_pk_bf16(O[4 * g4 + 0] * inv, O[4 * g4 + 1] * inv); w.y = pg8::cvt_pk_bf16(O[4 * g4 + 2] * inv, O[4 * g4 + 3] * inv); *(v2u*)(dst + off) = w; }
        if constexpr (MODE == 1) { if (hi == 0) LSE[(size_t)br * M * 16 + tq * 16 + it.h] = m + __builtin_amdgcn_logf(lt); }
    }
}
constexpr int CO_V = 65536;
template <int MODE>
__device__ __forceinline__ void att_epilogue(const f32x16& O0, const f32x16& O1, const float m, const float l, const size_t tq, const int h, const int hi, bf16* AO, bf16* OB, float* LSE, const int br) {
    const float lt = xor32_sum(l);
    const float inv = 1.0f / lt;
    if constexpr (MODE == 2) {
        const float lse3 = m + __builtin_amdgcn_logf(lt);
        const float lse1 = LSE[tq * 16 + h], lse2 = LSE[(size_t)M * 16 + tq * 16 + h];
        const float mm = fmaxf(lse3, fmaxf(lse1, lse2)), w1 = __builtin_amdgcn_exp2f(lse1 - mm), w2 = __builtin_amdgcn_exp2f(lse2 - mm), w3 = __builtin_amdgcn_exp2f(lse3 - mm), wi = 1.0f / (w1 + w2 + w3);
        const float c1 = w1 * wi, c2 = w2 * wi, c3 = w3 * wi * inv;
#pragma unroll
        for (int db = 0; db < 2; ++db)
#pragma unroll
            for (int g4 = 0; g4 < 4; ++g4) { const size_t off = tq * D + h * HD + 32 * db + 8 * g4 + 4 * hi;
                const v2u a1 = *(const v2u*)(OB + off), a2 = *(const v2u*)(OB + (size_t)M * D + off);
                const f32x16& O = db == 0 ? O0 : O1;
                const float x0 = c3 * O[4 * g4 + 0] + c1 * bflo(a1.x) + c2 * bflo(a2.x), x1 = c3 * O[4 * g4 + 1] + c1 * bfhi(a1.x) + c2 * bfhi(a2.x);
                const float x2 = c3 * O[4 * g4 + 2] + c1 * bflo(a1.y) + c2 * bflo(a2.y), x3 = c3 * O[4 * g4 + 3] + c1 * bfhi(a1.y) + c2 * bfhi(a2.y);
                v2u w; w.x = pg8::cvt_pk_bf16(x0, x1); w.y = pg8::cvt_pk_bf16(x2, x3); *(v2u*)(AO + off) = w; }
    } else {
        bf16* dst = MODE == 1 ? OB + (size_t)br * M * D : AO;
#pragma unroll
        for (int db = 0; db < 2; ++db)
#pragma unroll
            for (int g4 = 0; g4 < 4; ++g4) { const size_t off = ((size_t)h * M + tq) * HD + 32 * db + 8 * g4 + 4 * hi; const f32x16& O = db == 0 ? O0 : O1;
                v2u w; w.x = pg8::cvt_pk_bf16(O[4 * g4 + 0] * inv, O[4 * g4 + 1] * inv); w.y = pg8::cvt_pk_bf16(O[4 * g4 + 2] * inv, O[4 * g4 + 3] * inv); *(v2u*)(dst + off) = w; }
        if constexpr (MODE == 1) { if (hi == 0) LSE[(size_t)br * M * 16 + tq * 16 + h] = m + __builtin_amdgcn_logf(lt); }
    }
}
template <int KIND, int MODE>
__device__ __forceinline__ void attn_coop_phase(const bf16* Qb, const bf16* Kb, const bf16* Vb, const float* biasT, const float* extra, bf16* AO, bf16* OB, float* LSE,
                                                const int br, const int dil, LAS unsigned char* lds, const int tid, const int bx, const int G, const int wave, const int lane, const int nol = 0) {
    constexpr int W = KIND == 0 ? 128 : 64, NT = KIND == 0 ? 9 : 5, NH = KIND == 0 ? 4 : 1;
    const size_t rowB = (size_t)HD * 2;
    const int L = SEQ / dil, gpr = L / 256, lgp = dil == 16 ? 0 : (dil == 4 ? 2 : 4), nitems = KIND == 0 ? BATCH * 4 * 16 : BATCH * 16 * 16;
    const int tbid = KIND == 0 ? 0 : (dil == 16 ? 1 : (dil == 4 ? 2 : 3));
    const float* gtab = biasT + 65536 + tbid * 16 * AT_STRIDE;
    LAS unsigned char* Kl = lds + RING_OFF; LAS unsigned char* Vl = lds + RING_OFF + CO_V; LAS float* tabl = (LAS float*)(lds + VO_OFF);
    const int r = lane & 31, hi = lane >> 5, i16 = lane & 15, g4l = lane >> 4;
    int kfo[4];
#pragma unroll
    for (int st = 0; st < 4; ++st) kfo[st] = r * 128 + (((2 * st + hi) ^ (r & 7)) * 16);
    const int vrow = 4 * (g4l >> 1) + (i16 >> 2), vch = 2 * (g4l & 1) + ((i16 & 3) >> 1), vsw = 4 * ((i16 >> 3) & 1), vwi = 8 * (i16 & 1);
    const int vo0 = vrow * 128 + (vch + vsw) * 16 + vwi, vo1 = vrow * 128 + (vch + (4 - vsw)) * 16 + vwi;
    const int tb0 = 4 * (32 + 4 * hi - r);
#define CO_COORDS(item_, b_, kh_, h0_, res_, g_) do { if constexpr (KIND == 0) { g_ = (item_) & 15; kh_ = ((item_) >> 4) & 3; b_ = (item_) >> 6; res_ = 0; h0_ = kh_ * 4; } \
        else { const int idx_ = (item_) & 15; h0_ = ((item_) >> 4) & 15; b_ = (item_) >> 8; res_ = idx_ >> lgp; g_ = idx_ & (gpr - 1); kh_ = h0_; } } while (0)
#define CO_LOADQ(Q_, tq_, h_) do { _Pragma("unroll") for (int st = 0; st < 4; ++st) Q_[st] = *(const bf16x8*)(Qb + ((size_t)(h_) * M + (tq_)) * HD + 16 * st + 8 * hi); } while (0)
    const bool tab_once = (G % (KIND == 0 ? 64 : 256)) == 0;
    bf16x8 Qn[4];
    __syncthreads();
    if (bx < nitems) { int b, kh, h0, res, g; CO_COORDS(bx, b, kh, h0, res, g); (void)kh;
        CO_LOADQ(Qn, (size_t)b * SEQ + res + (size_t)dil * (g * 256 + 32 * wave + r), h0);
        if (tab_once) {
#pragma unroll
            for (int k = 0; k < (NH * 2 + NWAVES - 1) / NWAVES; ++k) { const int c1 = wave + NWAVES * k;
                if (c1 < NH * 2) __builtin_amdgcn_global_load_lds((const unsigned*)(gtab + (size_t)h0 * AT_STRIDE + c1 * 256 + lane * 4), (LAS unsigned*)((LAS unsigned char*)tabl + c1 * 1024), 16, 0, 0); } } }
    for (int item = bx; item < nitems; item += G) {
        int b, kh, h0, res, g; CO_COORDS(item, b, kh, h0, res, g);
        float sk[NH];
#pragma unroll
        for (int hs = 0; hs < NH; ++hs) sk[hs] = KIND == 0 ? extra[h0 + hs] : 0.f;
        const int i0g = g * 256, lo = i0g - W < 0 ? 0 : i0g - W, hie = i0g + 256 + W > L ? L : i0g + 256 + W, nrows = hie - lo;
        __syncthreads();
        { const char* kg = (const char*)Kb + ((size_t)kh * M + (size_t)b * SEQ + res) * rowB; const char* vg = (const char*)Vb + ((size_t)kh * M + (size_t)b * SEQ + res) * rowB;
          const int rin = lane >> 3, p = lane & 7;
#pragma unroll
          for (int j = 0; j < (KIND == 0 ? 8 : 6); ++j) { const int rg = wave + NWAVES * j, row = rg * 8 + rin;
              if (rg * 8 < nrows && !nol) { const size_t off = (size_t)(lo + row) * dil * rowB;
                  __builtin_amdgcn_global_load_lds((const unsigned*)(kg + off + ((p ^ (row & 7)) * 16)), (LAS unsigned*)(Kl + rg * 1024), 16, 0, 0);
                  __builtin_amdgcn_global_load_lds((const unsigned*)(vg + off + ((p ^ (4 * ((row >> 1) & 1))) * 16)), (LAS unsigned*)(Vl + rg * 1024), 16, 0, 0); } }
          if (!tab_once) {
#pragma unroll
              for (int k = 0; k < (NH * 2 + NWAVES - 1) / NWAVES; ++k) { const int c1 = wave + NWAVES * k;
                  if (c1 < NH * 2) __builtin_amdgcn_global_load_lds((const unsigned*)(gtab + (size_t)h0 * AT_STRIDE + c1 * 256 + lane * 4), (LAS unsigned*)((LAS unsigned char*)tabl + c1 * 1024), 16, 0, 0); } }
          __builtin_amdgcn_s_waitcnt(0x0F70); }
        __syncthreads();
        const int i0 = i0g + 32 * wave;
        const int tlo = i0 < W ? (W - i0) / 32 : 0, th_ = (L + W - i0) / 32, thi = th_ < NT ? th_ : NT;
        const size_t tq = (size_t)b * SEQ + res + (size_t)dil * (i0 + r);
#pragma unroll 1
        for (int hs = 0; hs < NH; ++hs) {
            const int h = h0 + hs;
            bf16x8 Qf[4];
#pragma unroll
            for (int st = 0; st < 4; ++st) Qf[st] = Qn[st];
            if (hs + 1 < NH) CO_LOADQ(Qn, tq, h + 1);
            else if (item + G < nitems) { int b2, kh2, h02, res2, g2; CO_COORDS(item + G, b2, kh2, h02, res2, g2); (void)kh2;
                CO_LOADQ(Qn, (size_t)b2 * SEQ + res2 + (size_t)dil * (g2 * 256 + 32 * wave + r), h02); }
            v2u pa1[8], pa2[8]; float lse1 = 0.f, lse2 = 0.f;
            if constexpr (MODE == 2) { lse1 = LSE[tq * 16 + h]; lse2 = LSE[(size_t)M * 16 + tq * 16 + h];
#pragma unroll
                for (int db = 0; db < 2; ++db)
#pragma unroll
                    for (int g4 = 0; g4 < 4; ++g4) { const size_t off = ((size_t)h * M + tq) * HD + 32 * db + 8 * g4 + 4 * hi; pa1[db * 4 + g4] = *(const v2u*)(OB + off); pa2[db * 4 + g4] = *(const v2u*)(OB + (size_t)M * D + off); } }
            float m = 0.f, l = 0.f;
            if constexpr (KIND == 0) { m = sk[hs] * LOG2E; l = hi == 0 ? 1.0f : 0.0f; }
            f32x16 O0, O1;
#pragma unroll
            for (int i = 0; i < 16; ++i) { O0[i] = 0.f; O1[i] = 0.f; }
            const LAS unsigned char* tabb = (const LAS unsigned char*)(tabl + hs * AT_STRIDE) + tb0;
            int rbB = (i0 - W + 32 * tlo - lo) * 128;
            bf16x8 Kf[4];
#pragma unroll
            for (int st = 0; st < 4; ++st) Kf[st] = *(const LAS bf16x8*)(Kl + rbB + kfo[st]);
            f32x16 Sc = att_qk(Kf, Qf);
            for (int t = tlo; t < thi; ++t) {
                if (t + 1 < thi) {
#pragma unroll
                    for (int st = 0; st < 4; ++st) Kf[st] = *(const LAS bf16x8*)(Kl + rbB + 4096 + kfo[st]); }
                v4i16 Vt[8];
#pragma unroll
                for (int s2 = 0; s2 < 2; ++s2) {
                    Vt[(s2 * 2 + 0) * 2 + 0] = __builtin_amdgcn_ds_read_tr16_b64_v4i16((LAS v4i16*)(Vl + rbB + vo0 + (16 * s2) * 128));
                    Vt[(s2 * 2 + 0) * 2 + 1] = __builtin_amdgcn_ds_read_tr16_b64_v4i16((LAS v4i16*)(Vl + rbB + vo0 + (16 * s2 + 8) * 128));
                    Vt[(s2 * 2 + 1) * 2 + 0] = __builtin_amdgcn_ds_read_tr16_b64_v4i16((LAS v4i16*)(Vl + rbB + vo1 + (16 * s2) * 128));
                    Vt[(s2 * 2 + 1) * 2 + 1] = __builtin_amdgcn_ds_read_tr16_b64_v4i16((LAS v4i16*)(Vl + rbB + vo1 + (16 * s2 + 8) * 128)); }
                float bs[16];
                { const LAS float* tp = (const LAS float*)(tabb + t * 128); asm volatile("" : "+v"(tp));
#pragma unroll
                  for (int i = 0; i < 16; ++i) bs[i] = tp[(i & 3) + 8 * (i >> 2)]; }
                __builtin_amdgcn_sched_barrier(0);
                f32x16 Sn = Sc;
                if (t + 1 < thi) Sn = att_qk(Kf, Qf);
                att_soft_pv(O0, O1, m, l, Sc, Vt, bs, lane);
                Sc = Sn; rbB += 4096;
            }
            if constexpr (MODE == 2) {
                const float lt = xor32_sum(l), inv = 1.0f / lt;
                const float lse3 = m + __builtin_amdgcn_logf(lt);
                const float mm = fmaxf(lse3, fmaxf(lse1, lse2)), w1 = __builtin_amdgcn_exp2f(lse1 - mm), w2 = __builtin_amdgcn_exp2f(lse2 - mm), w3 = __builtin_amdgcn_exp2f(lse3 - mm), wi = 1.0f / (w1 + w2 + w3);
                const float c1 = w1 * wi, c2 = w2 * wi, c3 = w3 * wi * inv;
#pragma unroll
                for (int db = 0; db < 2; ++db)
#pragma unroll
                    for (int g4 = 0; g4 < 4; ++g4) { const size_t off = ((size_t)h * M + tq) * HD + 32 * db + 8 * g4 + 4 * hi;
                        const unsigned a1x = pa1[db * 4 + g4].x, a1y = pa1[db * 4 + g4].y, a2x = pa2[db * 4 + g4].x, a2y = pa2[db * 4 + g4].y;
                        const f32x16& O = db == 0 ? O0 : O1;
                        const float x0 = c3 * O[4 * g4 + 0] + c1 * bflo(a1x) + c2 * bflo(a2x), x1 = c3 * O[4 * g4 + 1] + c1 * bfhi(a1x) + c2 * bfhi(a2x);
                        const float x2 = c3 * O[4 * g4 + 2] + c1 * bflo(a1y) + c2 * bflo(a2y), x3 = c3 * O[4 * g4 + 3] + c1 * bfhi(a1y) + c2 * bfhi(a2y);
                        v2u w; w.x = pg8::cvt_pk_bf16(x0, x1); w.y = pg8::cvt_pk_bf16(x2, x3); *(v2u*)(AO + off) = w; }
            } else att_epilogue<MODE>(O0, O1, m, l, tq, h, hi, AO, OB, LSE, br);
        }
    }
#undef CO_COORDS
#undef CO_LOADQ
    __syncthreads();
}
__device__ __forceinline__ void attn_coopC_phase(const bf16* Qb, const bf16* Kb, const bf16* Vb, const float* biasT, bf16* AO, LAS unsigned char* lds, const int tid, const int vcu, const int G,
                                                 const int wave, const int lane) {
    (void)tid;
    constexpr int CV_OFF = 9 * 8192;
    LAS unsigned char* Kl = lds + RING_OFF; LAS unsigned char* Vl = lds + RING_OFF + CV_OFF; LAS float* tab = (LAS float*)(lds + TABB_OFF);
    const float* gtab = biasT + 65536 + 4 * 16 * AT_STRIDE;
    const int r = lane & 31, hi = lane >> 5, i16 = lane & 15, g4l = lane >> 4;
    int kfo[4];
#pragma unroll
    for (int st = 0; st < 4; ++st) kfo[st] = r * 128 + (((2 * st + hi) ^ (r & 7)) * 16);
    const int vrow = 4 * (g4l >> 1) + (i16 >> 2), vch = 2 * (g4l & 1) + ((i16 & 3) >> 1), vsw = 4 * ((i16 >> 3) & 1), vwi = 8 * (i16 & 1);
    const int vo0 = vrow * 128 + (vch + vsw) * 16 + vwi, vo1 = vrow * 128 + (vch + (4 - vsw)) * 16 + vwi;
    const int qb = wave & 3, part = wave >> 2;
    const int c0 = 16 * qb, cb = iclamp(c0 - 8, 0, 32), cq = c0 + (r & 15), csq = iclamp(cq - 8, 0, 48), w0 = csq - cb;
    float cneg[16];
#pragma unroll
    for (int i = 0; i < 16; ++i) cneg[i] = ((unsigned)(crow(i, hi) - w0) < 16u) ? 0.f : -1e30f;
    const int tb0 = 4 * (16 + (cb - cq + 15) + 4 * hi);
    LAS float* mrg = (LAS float*)(lds + MRG_OFF) + qb * 128 + lane * 2;
#define CC_LOADQ(Q_, tq_, h_) do { _Pragma("unroll") for (int st = 0; st < 4; ++st) Q_[st] = *(const bf16x8*)(Qb + ((size_t)(h_) * M + (tq_)) * HD + 16 * st + 8 * hi); } while (0)
    for (int band = vcu; band < BATCH * H * 2; band += G) {
        const int b = band >> 5, h = (band >> 1) & 15, half = band & 1;
        const char* kg = (const char*)Kb + ((size_t)h * M + (size_t)b * SEQ) * (HD * 2); const char* vg = (const char*)Vb + ((size_t)h * M + (size_t)b * SEQ) * (HD * 2);
        __syncthreads();
        if (wave < 2) __builtin_amdgcn_global_load_lds((const unsigned*)(gtab + (size_t)h * AT_STRIDE + wave * 256 + lane * 4), (LAS unsigned*)((LAS unsigned char*)tab + wave * 1024), 16, 0, 0);
        int have = -1;
        bf16x8 Qn[4];
        CC_LOADQ(Qn, (size_t)b * SEQ + (size_t)(32 * half + (r >> 4)) * 64 + c0 + (r & 15), h);
        for (int ip = 0; ip < 16; ++ip) {
            const int R = 32 * half + 2 * ip, lo = iclamp(R - 4, 0, 56), hir = iclamp(R - 3, 0, 56) + 7, thi = hir - lo + 1;
            if (ip) __syncthreads();
            { const int n0 = have + 1 > lo ? have + 1 : lo; const int col = 8 * wave + (lane >> 3), p = lane & 7;
              for (int kr = n0; kr <= hir; ++kr) { const int slot = kr % 9; const size_t off = (size_t)(kr * 64 + col) * (HD * 2);
                  __builtin_amdgcn_global_load_lds((const unsigned*)(kg + off + ((p ^ (lane >> 3)) * 16)), (LAS unsigned*)(Kl + slot * 8192 + wave * 1024), 16, 0, 0);
                  __builtin_amdgcn_global_load_lds((const unsigned*)(vg + off + ((p ^ (4 * ((lane >> 4) & 1))) * 16)), (LAS unsigned*)(Vl + slot * 8192 + wave * 1024), 16, 0, 0); }
              have = hir; }
            __builtin_amdgcn_s_waitcnt(0x0F70);
            __syncthreads();
            bf16x8 Qf[4];
#pragma unroll
            for (int st = 0; st < 4; ++st) Qf[st] = Qn[st];
            if (ip + 1 < 16) CC_LOADQ(Qn, (size_t)b * SEQ + (size_t)(R + 2 + (r >> 4)) * 64 + c0 + (r & 15), h);
            const size_t tq = (size_t)b * SEQ + (size_t)(R + (r >> 4)) * 64 + c0 + (r & 15);
            const int rq = R + (r >> 4), rsq = iclamp(rq - 4, 0, 56);
            const int nh = (thi + 1) >> 1, t0 = part ? nh : 0, t1 = part ? thi : nh;
            float m = 0.f, l = 0.f;
            f32x16 O0, O1;
#pragma unroll
            for (int i = 0; i < 16; ++i) { O0[i] = 0.f; O1[i] = 0.f; }
            bf16x8 Kf[4];
            { const int sb = ((lo + t0) % 9) * 8192 + cb * 128;
#pragma unroll
              for (int st = 0; st < 4; ++st) Kf[st] = *(const LAS bf16x8*)(Kl + sb + kfo[st]); }
            f32x16 Sc = att_qk(Kf, Qf);
            for (int t = t0; t < t1; ++t) {
                const int kr2 = lo + t, sb = (kr2 % 9) * 8192 + cb * 128;
                if (t + 1 < t1) { const int sbn = ((kr2 + 1) % 9) * 8192 + cb * 128;
#pragma unroll
                    for (int st = 0; st < 4; ++st) Kf[st] = *(const LAS bf16x8*)(Kl + sbn + kfo[st]); }
                v4i16 Vt[8];
#pragma unroll
                for (int s2 = 0; s2 < 2; ++s2) {
                    Vt[(s2 * 2 + 0) * 2 + 0] = __builtin_amdgcn_ds_read_tr16_b64_v4i16((LAS v4i16*)(Vl + sb + vo0 + (16 * s2) * 128));
                    Vt[(s2 * 2 + 0) * 2 + 1] = __builtin_amdgcn_ds_read_tr16_b64_v4i16((LAS v4i16*)(Vl + sb + vo0 + (16 * s2 + 8) * 128));
                    Vt[(s2 * 2 + 1) * 2 + 0] = __builtin_amdgcn_ds_read_tr16_b64_v4i16((LAS v4i16*)(Vl + sb + vo1 + (16 * s2) * 128));
                    Vt[(s2 * 2 + 1) * 2 + 1] = __builtin_amdgcn_ds_read_tr16_b64_v4i16((LAS v4i16*)(Vl + sb + vo1 + (16 * s2 + 8) * 128)); }
                float bt[16];
                { const LAS float* tp = (const LAS float*)((const LAS unsigned char*)tab + tb0 + 4 * 31 * iclamp(kr2 - rq + 7, 0, 14)); asm volatile("" : "+v"(tp));
#pragma unroll
                  for (int i = 0; i < 16; ++i) bt[i] = tp[(i & 3) + 8 * (i >> 2)]; }
                __builtin_amdgcn_sched_barrier(0);
                f32x16 Sn = Sc;
                if (t + 1 < t1) Sn = att_qk(Kf, Qf);
                float bs[16];
                { const float rneg = (kr2 >= rsq && kr2 < rsq + 8) ? 0.f : -1e30f;
#pragma unroll
                  for (int i = 0; i < 16; ++i) bs[i] = bt[i] + (cneg[i] + rneg); }
                att_soft_pv(O0, O1, m, l, Sc, Vt, bs, lane);
                Sc = Sn;
            }
            const float lt = xor32_sum(l);
            LAS unsigned char* hov = ((qb & 2) ? Vl : Kl) + ((thi == 8 ? lo + 8 : lo) % 9) * 8192 + (qb & 1) * 4096 + lane * 64;
            __syncthreads();
            if (part) {
                const float inv = lt > 0.f ? 1.0f / lt : 0.f;
#pragma unroll
                for (int db = 0; db < 2; ++db) { const f32x16& O = db == 0 ? O0 : O1;
#pragma unroll
                    for (int g2 = 0; g2 < 2; ++g2) { v4u w;
                        w.x = pg8::cvt_pk_bf16(O[8 * g2 + 0] * inv, O[8 * g2 + 1] * inv); w.y = pg8::cvt_pk_bf16(O[8 * g2 + 2] * inv, O[8 * g2 + 3] * inv);
                        w.z = pg8::cvt_pk_bf16(O[8 * g2 + 4] * inv, O[8 * g2 + 5] * inv); w.w = pg8::cvt_pk_bf16(O[8 * g2 + 6] * inv, O[8 * g2 + 7] * inv);
                        *(LAS v4u*)(hov + (db * 2 + g2) * 16) = w; } }
                mrg[0] = m; mrg[1] = lt;
            }
            __syncthreads();
            if (!part) {
                const float mb = mrg[0], lb = mrg[1];
                const float mm = fmaxf(m, mb), sa = __builtin_amdgcn_exp2f(m - mm), sb2 = __builtin_amdgcn_exp2f(mb - mm) * lb, invL = 1.0f / (lt * sa + sb2), ca = sa * invL, cbw = sb2 * invL;
#pragma unroll
                for (int db = 0; db < 2; ++db) { const f32x16& O = db == 0 ? O0 : O1;
#pragma unroll
                    for (int g2 = 0; g2 < 2; ++g2) { const v4u pw = *(const LAS v4u*)(hov + (db * 2 + g2) * 16);
                        const unsigned p0 = pw.x, p1 = pw.y, p2 = pw.z, p3 = pw.w;
                        const float x0 = O[8 * g2 + 0] * ca + bflo(p0) * cbw, x1 = O[8 * g2 + 1] * ca + bfhi(p0) * cbw, x2 = O[8 * g2 + 2] * ca + bflo(p1) * cbw, x3 = O[8 * g2 + 3] * ca + bfhi(p1) * cbw;
                        const float x4 = O[8 * g2 + 4] * ca + bflo(p2) * cbw, x5 = O[8 * g2 + 5] * ca + bfhi(p2) * cbw, x6 = O[8 * g2 + 6] * ca + bflo(p3) * cbw, x7 = O[8 * g2 + 7] * ca + bfhi(p3) * cbw;
                        { v2u w; w.x = pg8::cvt_pk_bf16(x0, x1); w.y = pg8::cvt_pk_bf16(x2, x3); *(v2u*)(AO + ((size_t)h * M + tq) * HD + 32 * db + 8 * (2 * g2) + 4 * hi) = w; }
                        { v2u w; w.x = pg8::cvt_pk_bf16(x4, x5); w.y = pg8::cvt_pk_bf16(x6, x7); *(v2u*)(AO + ((size_t)h * M + tq) * HD + 32 * db + 8 * (2 * g2 + 1) + 4 * hi) = w; } } }
            }
        }
    }
#undef CC_LOADQ
    __syncthreads();
}
template <int KIND, int MODE, bool NOLOAD = false>
__device__ __forceinline__ void attn_phase_mfma(const bf16* Qb, const bf16* Kb, const bf16* Vb, const float* biasT, const float* extra, bf16* AO, bf16* OB, float* LSE,
                                                const int br, const int dil, LAS unsigned char* lds, const int gw, const int NGW, const int wave, const int lane) {
    LAS unsigned char* wl = lds + RING_OFF + wave * AW_BYTES;
    LAS float* tabs = (LAS float*)(lds + RING_OFF + AT_OFF);
    __syncthreads();
    { const int tbid = KIND == 0 ? 0 : (KIND == 2 ? 4 : (dil == 16 ? 1 : (dil == 4 ? 2 : 3)));
      const v4u* src = (const v4u*)(biasT + 65536 + tbid * 16 * AT_STRIDE); v4u tv[4];
#pragma unroll
      for (int k = 0; k < 4; ++k) tv[k] = src[wave * 64 + lane + NWAVES * 64 * k];
#pragma unroll
      for (int k = 0; k < 4; ++k) ((LAS v4u*)tabs)[wave * 64 + lane + NWAVES * 64 * k] = tv[k]; }
    __syncthreads();
    for (int wi = gw; wi < (M / 32) * H; wi += NGW) {
        AttItem it; const int bh = wi >> 7, idx = wi & 127;
        it.b = bh >> 4; it.h = bh & 15; it.kh = KIND == 0 ? (it.h >> 2) : it.h; it.dil = dil; it.res = 0; it.L = SEQ; it.R = 0; it.c0 = 0; it.cb = 0; it.rs0 = 0; it.q0 = 0;
        if constexpr (KIND == 0) { it.q0 = idx * 32; it.tlo = it.q0 < 128 ? (128 - it.q0) / 32 : 0; const int th = (SEQ + 128 - it.q0) / 32; it.thi = th < 9 ? th : 9; }
        else if constexpr (KIND == 1) { it.L = SEQ / dil; const int nb = it.L / 32; it.res = idx / nb; it.q0 = (idx % nb) * 32; it.tlo = it.q0 < 64 ? (64 - it.q0) / 32 : 0; const int th = (it.L + 64 - it.q0) / 32; it.thi = th < 5 ? th : 5; }
        else { it.R = (idx >> 2) * 2; it.c0 = (idx & 3) * 16; it.cb = iclamp(it.c0 - 8, 0, 32); it.rs0 = iclamp(it.R - 4, 0, 56); it.tlo = 0; it.thi = iclamp(it.R + 1 - 4, 0, 56) + 8 - it.rs0; }
        if (MK_DRYA == 6 && NOLOAD) it.thi = it.tlo + 1;
        attn_item<KIND, MODE, NOLOAD>(it, Qb, Kb, Vb, KIND == 0 ? 256 : D, biasT, extra, AO, OB, LSE, br, wl, tabs, lane);
    }
}

#define LN_STATS(v, mean, rstd) do { float s_ = 0.f; _Pragma("unroll") for (int j_ = 0; j_ < 4; ++j_) s_ += (v[j_].x + v[j_].y) + (v[j_].z + v[j_].w); \
        mean = wave_sum(s_) * (1.f / D); float s2_ = 0.f; \
        _Pragma("unroll") for (int j_ = 0; j_ < 4; ++j_) { const f32x4 d_ = v[j_] - mean; s2_ += (d_.x * d_.x + d_.y * d_.y) + (d_.z * d_.z + d_.w * d_.w); } \
        rstd = 1.0f / sqrtf(wave_sum(s2_) * (1.f / D) + LN_EPS); } while (0)

__device__ __forceinline__ int lane_get(int v, int src, int lane) { (void)lane; return __builtin_amdgcn_ds_bpermute(src << 2, v); }
__device__ __forceinline__ float lane_getf(float v, int src) { return __builtin_bit_cast(float, __builtin_amdgcn_ds_bpermute(src << 2, __builtin_bit_cast(int, v))); }
constexpr float LN1_WSC = 256.f, LN1_XSC = 64.f, LN1_DSC = 1.f / (256.f * 64.f);
__device__ __forceinline__ v2u split2h(float a, float b) {
    f16x2 h; h.x = (_Float16)a; h.y = (_Float16)b;
    f16x2 l; l.x = (_Float16)(a - (float)h.x); l.y = (_Float16)(b - (float)h.y);
    v2u o; o.x = __builtin_bit_cast(unsigned, h); o.y = __builtin_bit_cast(unsigned, l); return o;
}
#define LN1_SPLIT8(H_, L_, t_, sc_) do { const v2u p0_ = split2h((t_)[0] * (sc_), (t_)[1] * (sc_)), p1_ = split2h((t_)[2] * (sc_), (t_)[3] * (sc_)), p2_ = split2h((t_)[4] * (sc_), (t_)[5] * (sc_)), p3_ = split2h((t_)[6] * (sc_), (t_)[7] * (sc_)); \
        (H_).x = p0_.x; (H_).y = p1_.x; (H_).z = p2_.x; (H_).w = p3_.x; (L_).x = p0_.y; (L_).y = p1_.y; (L_).z = p2_.y; (L_).w = p3_.y; } while (0)
constexpr int LN1_PS = 52;
__device__ __forceinline__ void ln1_router_phase(const bf16* hin, const bf16* Y, const LayerP& P, bf16* hb, unsigned* cntw, int* tok2, unsigned* ti,
                                                 LAS unsigned char* lds, int tid, int vcu, int G, int lane, int wave) {
    const int r = lane & 15, q = lane >> 4, cb = 128 * wave + 8 * q;
    LAS float* gL = (LAS float*)(lds + VO_OFF);
    LAS float* st1 = (LAS float*)(lds + RING_OFF); LAS float* st2 = st1 + 128; LAS float* part = st1 + 256;
    v4u hw[4], yw[4];
#define LN1_LOAD(g_) do { const size_t o_ = (size_t)((g_) * 16 + r) * D + cb; _Pragma("unroll") for (int s = 0; s < 4; ++s) { hw[s] = *(const v4u*)(hin + o_ + 32 * s); yw[s] = *(const v4u*)(Y + o_ + 32 * s); } } while (0)
    const int NG = M / 16;
    if (vcu < NG) LN1_LOAD(vcu);
    const f32x4 gb4 = tid < 256 ? ((const f32x4*)P.ln1g)[tid] : ((const f32x4*)P.ln1b)[tid - 256];
    v4u WH[3][4], WL[3][4];
#pragma unroll
    for (int s = 0; s < 4; ++s) {
        float t0[8], t1[8], t2[8];
#pragma unroll
        for (int j = 0; j < 8; ++j) { const int col = cb + 32 * s + j; t0[j] = P.rew[col * 32 + r]; t1[j] = P.rew[col * 32 + 16 + r]; t2[j] = P.rgw[col * 4 + (r & 3)]; }
        if (r >= 4) {
#pragma unroll
            for (int j = 0; j < 8; ++j) t2[j] = 0.f; }
        LN1_SPLIT8(WH[0][s], WL[0][s], t0, LN1_WSC); LN1_SPLIT8(WH[1][s], WL[1][s], t1, LN1_WSC); LN1_SPLIT8(WH[2][s], WL[2][s], t2, LN1_WSC);
    }
    const float reb_e = P.reb[lane & 31], rgb_e = P.rgb[lane & 3];
    ((LAS f32x4*)gL)[tid] = gb4;
    LAS unsigned* cntL = (LAS unsigned*)(lds + RING_OFF + 61440);
    if (tid < 64) cntL[tid] = 0u;
    __syncthreads();
    int me0 = 0, me1 = 0, mt = 0; float mg0 = 0.f, mg1 = 0.f; int it = 0;
    for (int gi = vcu; gi < NG; gi += G, ++it) {
        const size_t o = (size_t)(gi * 16 + r) * D + cb;
        float v[32];
#pragma unroll
        for (int s = 0; s < 4; ++s) { const unsigned y0 = yw[s].x, y1 = yw[s].y, y2 = yw[s].z, y3 = yw[s].w, h0 = hw[s].x, h1 = hw[s].y, h2 = hw[s].z, h3 = hw[s].w;
            v[8 * s + 0] = ALPHA * hlo(h0) + bflo(y0); v[8 * s + 1] = ALPHA * hhi(h0) + bfhi(y0); v[8 * s + 2] = ALPHA * hlo(h1) + bflo(y1); v[8 * s + 3] = ALPHA * hhi(h1) + bfhi(y1);
            v[8 * s + 4] = ALPHA * hlo(h2) + bflo(y2); v[8 * s + 5] = ALPHA * hhi(h2) + bfhi(y2); v[8 * s + 6] = ALPHA * hlo(h3) + bflo(y3); v[8 * s + 7] = ALPHA * hhi(h3) + bfhi(y3); }
        if (gi + G < NG) LN1_LOAD(gi + G);
        float s1 = 0.f;
#pragma unroll
        for (int kk = 0; kk < 32; kk += 4) s1 += (v[kk] + v[kk + 1]) + (v[kk + 2] + v[kk + 3]);
        float s2 = 0.f;
        { const float ml = s1 * (1.f / 32.f);
#pragma unroll
          for (int kk = 0; kk < 32; kk += 2) { const float d0 = v[kk] - ml, d1 = v[kk + 1] - ml; s2 += d0 * d0 + d1 * d1; } }
        { const float so = lane_getf(s1, lane ^ 16), mo = lane_getf(s2, lane ^ 16), dd = (s1 - so) * (1.f / 32.f); s2 += mo + 16.f * dd * dd; s1 += so; }
        { const float so = lane_getf(s1, lane ^ 32), mo = lane_getf(s2, lane ^ 32), dd = (s1 - so) * (1.f / 64.f); s2 += mo + 32.f * dd * dd; s1 += so; }
        if (q == 0) { st1[wave * 16 + r] = s1; st2[wave * 16 + r] = s2; }
        __syncthreads();
        float mean = 0.f, var = 0.f;
        { float sw[8];
#pragma unroll
          for (int w = 0; w < 8; ++w) { sw[w] = st1[w * 16 + r]; mean += sw[w]; var += st2[w * 16 + r]; }
          mean *= (1.f / D);
#pragma unroll
          for (int w = 0; w < 8; ++w) { const float dd = sw[w] * (1.f / 128.f) - mean; var += 128.f * dd * dd; } }
        const float rstd = 1.0f / sqrtf(var * (1.f / D) + LN_EPS);
#pragma unroll
        for (int s = 0; s < 4; ++s) { const int c4 = (cb + 32 * s) >> 2;
            const f32x4 ga = ((const LAS f32x4*)gL)[c4], gb = ((const LAS f32x4*)gL)[c4 + 1], ba = ((const LAS f32x4*)gL)[256 + c4], bb = ((const LAS f32x4*)gL)[256 + c4 + 1];
            f32x4 xa, xb;
            xa.x = (v[8 * s + 0] - mean) * rstd * ga.x + ba.x; xa.y = (v[8 * s + 1] - mean) * rstd * ga.y + ba.y; xa.z = (v[8 * s + 2] - mean) * rstd * ga.z + ba.z; xa.w = (v[8 * s + 3] - mean) * rstd * ga.w + ba.w;
            xb.x = (v[8 * s + 4] - mean) * rstd * gb.x + bb.x; xb.y = (v[8 * s + 5] - mean) * rstd * gb.y + bb.y; xb.z = (v[8 * s + 6] - mean) * rstd * gb.z + bb.z; xb.w = (v[8 * s + 7] - mean) * rstd * gb.w + bb.w;
            v4u w; w.x = pkh(xa.x, xa.y); w.y = pkh(xa.z, xa.w); w.z = pkh(xb.x, xb.y); w.w = pkh(xb.z, xb.w); *(v4u*)(hb + o + 32 * s) = w;
            v[8 * s + 0] = xa.x; v[8 * s + 1] = xa.y; v[8 * s + 2] = xa.z; v[8 * s + 3] = xa.w; v[8 * s + 4] = xb.x; v[8 * s + 5] = xb.y; v[8 * s + 6] = xb.z; v[8 * s + 7] = xb.w; }
        f32x4 a0 = {0.f, 0.f, 0.f, 0.f}, a1 = a0, a2 = a0;
#pragma unroll
        for (int s = 0; s < 4; ++s) { v4u xh, xl;
            LN1_SPLIT8(xh, xl, v + 8 * s, LN1_XSC);
            const f16x8 XH = __builtin_bit_cast(f16x8, xh), XL = __builtin_bit_cast(f16x8, xl);
            a0 = __builtin_amdgcn_mfma_f32_16x16x32_f16(XH, __builtin_bit_cast(f16x8, WH[0][s]), a0, 0, 0, 0); a1 = __builtin_amdgcn_mfma_f32_16x16x32_f16(XH, __builtin_bit_cast(f16x8, WH[1][s]), a1, 0, 0, 0);
            a2 = __builtin_amdgcn_mfma_f32_16x16x32_f16(XH, __builtin_bit_cast(f16x8, WH[2][s]), a2, 0, 0, 0);
            a0 = __builtin_amdgcn_mfma_f32_16x16x32_f16(XL, __builtin_bit_cast(f16x8, WH[0][s]), a0, 0, 0, 0); a1 = __builtin_amdgcn_mfma_f32_16x16x32_f16(XL, __builtin_bit_cast(f16x8, WH[1][s]), a1, 0, 0, 0);
            a2 = __builtin_amdgcn_mfma_f32_16x16x32_f16(XL, __builtin_bit_cast(f16x8, WH[2][s]), a2, 0, 0, 0);
            a0 = __builtin_amdgcn_mfma_f32_16x16x32_f16(XH, __builtin_bit_cast(f16x8, WL[0][s]), a0, 0, 0, 0); a1 = __builtin_amdgcn_mfma_f32_16x16x32_f16(XH, __builtin_bit_cast(f16x8, WL[1][s]), a1, 0, 0, 0);
            a2 = __builtin_amdgcn_mfma_f32_16x16x32_f16(XH, __builtin_bit_cast(f16x8, WL[2][s]), a2, 0, 0, 0); }
        a0 *= LN1_DSC; a1 *= LN1_DSC; a2 *= LN1_DSC;
        { LAS float* pw = part + wave * (16 * LN1_PS) + (4 * q) * LN1_PS + r;
#pragma unroll
          for (int i = 0; i < 4; ++i) { pw[i * LN1_PS] = a0[i]; pw[i * LN1_PS + 16] = a1[i]; pw[i * LN1_PS + 32] = a2[i]; } }
        __syncthreads();
        { const int half = lane >> 5, e = lane & 31, tk = 2 * wave + half;
          const LAS float* pr = part + tk * LN1_PS;
          float le_ = 0.f, lg_ = 0.f;
#pragma unroll
          for (int w = 0; w < 8; ++w) { le_ += pr[w * (16 * LN1_PS) + e]; lg_ += pr[w * (16 * LN1_PS) + 32 + (e & 3)]; }
          le_ += reb_e; lg_ += rgb_e;
          float lg[4];
#pragma unroll
          for (int c = 0; c < 4; ++c) lg[c] = lane_getf(lg_, (lane & 32) + c);
          int grp = 0; float lmax = lg[0];
#pragma unroll
          for (int i = 1; i < 4; ++i) if (lg[i] > lmax) { lmax = lg[i]; grp = i; }
          float den = 0.f;
#pragma unroll
          for (int i = 0; i < 4; ++i) den += expf(lg[i] - lmax);
          const float pg = 1.0f / den;
          float le[8];
#pragma unroll
          for (int i = 0; i < 8; ++i) le[i] = lane_getf(le_, (lane & 32) + grp * 8 + i);
          int i0 = 0; float v0 = le[0];
#pragma unroll
          for (int i = 1; i < 8; ++i) if (le[i] > v0) { v0 = le[i]; i0 = i; }
          int i1 = -1; float v1 = -3.0e38f;
#pragma unroll
          for (int i = 0; i < 8; ++i) if (i != i0 && le[i] > v1) { v1 = le[i]; i1 = i; }
          const float dd = expf(v1 - v0), g0 = pg / (1.0f + dd), g1 = pg * dd / (1.0f + dd);
          if (e == it) { me0 = grp * 8 + i0; me1 = grp * 8 + i1; mg0 = g0; mg1 = g1; mt = gi * 16 + tk; } }
    }
#undef LN1_LOAD
    { const int row = lane >> 1, slot = lane & 1, srcl = (row >> 1) + 32 * (row & 1);
      const int e0r = lane_get(me0, srcl, lane), e1r = lane_get(me1, srcl, lane), tr = lane_get(mt, srcl, lane);
      const float g0r = lane_getf(mg0, srcl), g1r = lane_getf(mg1, srcl);
      const bool act = row < 2 * it; const int e = slot ? e1r : e0r;
      unsigned rank = 0u;
      if (act) rank = __hip_atomic_fetch_add(cntL + e, 1u, __ATOMIC_RELAXED, __HIP_MEMORY_SCOPE_WORKGROUP);
      LDS_WAIT(); __syncthreads();
      if (tid < 32) { const unsigned c = cntL[tid]; cntL[32 + tid] = c ? __hip_atomic_fetch_add(cntw + tid * 32, c, RLX_AGENT) : 0u; }
      __syncthreads();
      if (act) { rank += cntL[32 + e]; tok2[(size_t)e * 32768 + rank] = tr; }
      const unsigned rother = (unsigned)lane_get((int)rank, lane ^ 1, lane);
      if (act && slot == 0) { v4u a; a.x = (unsigned)e0r; a.y = (unsigned)e1r; a.z = rank; a.w = rother; ((v4u*)ti)[2 * tr] = a;
                              f32x2 gq; gq.x = g0r; gq.y = g1r; ((f32x2*)(ti + 8 * M))[tr] = gq; } }
    __syncthreads();
}
__device__ __forceinline__ void build_moe_tables(unsigned* cntw, LAS unsigned char* lds, int tid) {
    LAS int* tb = (LAS int*)(lds + TB_OFF); LAS int* cnt = (LAS int*)(lds + CNT_OFF);
    __syncthreads();
    if (tid < 64) {
        const int e = tid & 31, c = (int)__hip_atomic_load(cntw + e * 32, RLX_AGENT), nt = (c + 255) >> 8;
        int incl = nt;
#pragma unroll
        for (int d = 1; d < 32; d <<= 1) { const int o = __builtin_amdgcn_ds_bpermute(((tid & 32) + ((e - d) & 31)) << 2, incl); if (e >= d) incl += o; }
        if (tid < 32) { cnt[e] = c; tb[e] = incl - nt; if (e == 31) tb[32] = incl; }
    }
    __syncthreads();
    if (tid < 320) { int e = 0;
#pragma unroll
        for (int j = 1; j < 32; ++j) e += (tb[j] <= tid) ? 1 : 0;
        const int k = tid - tb[e]; int nv = cnt[e] - k * 256; nv = nv > 256 ? 256 : (nv < 0 ? 0 : nv); ((LAS unsigned*)(lds + TE_OFF))[tid] = (unsigned)e | ((unsigned)nv << 8) | ((unsigned)(k & 0xfff) << 20); }
    __syncthreads();
}
__device__ __forceinline__ void ln2_combine_phase(const bf16* hio, float* hout2, const bool wr32, const bf16* YS, const LayerP& P, bf16* hb, const unsigned* ti, LAS unsigned char* lds, int gw, int NGW, int lane) {
    const LAS int* tb = (const LAS int*)(lds + TB_OFF);
    const f32x4* g4 = (const f32x4*)P.ln2g; const f32x4* b4 = (const f32x4*)P.ln2b;
    v4u ra = {0u, 0u, 0u, 0u}; f32x2 rg = {0.f, 0.f};
    { const int tl = gw + lane * NGW; if (tl < M) { ra = ((const v4u*)ti)[2 * tl]; rg = ((const f32x2*)(ti + 8 * M))[tl]; } }
    const float rgxf = rg.x, rgyf = rg.y; const int rgx = __builtin_bit_cast(int, rgxf), rgy = __builtin_bit_cast(int, rgyf);
    f32x4 gr[4], br_[4];
#pragma unroll
    for (int j = 0; j < 4; ++j) { gr[j] = g4[64 * j + lane]; br_[j] = b4[64 * j + lane]; }
    v2u hw[4], y0[4], y1[4];
#define LN2_LOAD(k_, t_) do { const int e0_ = __builtin_amdgcn_readlane((int)ra.x, (k_)), e1_ = __builtin_amdgcn_readlane((int)ra.y, (k_)); \
        const size_t s0_ = (size_t)__builtin_amdgcn_readfirstlane(tb[e0_]) * 256 + (unsigned)__builtin_amdgcn_readlane((int)ra.z, (k_)), s1_ = (size_t)__builtin_amdgcn_readfirstlane(tb[e1_]) * 256 + (unsigned)__builtin_amdgcn_readlane((int)ra.w, (k_)); \
        _Pragma("unroll") for (int j = 0; j < 4; ++j) { hw[j] = ((const v2u*)(hio + (size_t)(t_) * D))[64 * j + lane]; y0[j] = ((const v2u*)(YS + s0_ * D))[64 * j + lane]; y1[j] = ((const v2u*)(YS + s1_ * D))[64 * j + lane]; } } while (0)
    int k = 0;
    if (gw < M) LN2_LOAD(0, gw);
    for (int t = gw; t < M; t += NGW, ++k) {
        const float g0 = __builtin_bit_cast(float, __builtin_amdgcn_readlane(rgx, k)), g1 = __builtin_bit_cast(float, __builtin_amdgcn_readlane(rgy, k));
        f32x4 v[4];
#pragma unroll
        for (int j = 0; j < 4; ++j) {
            const unsigned h0 = hw[j].x, h1 = hw[j].y;
            v[j].x = ALPHA * hlo(h0) + (g0 * bflo(y0[j].x) + g1 * bflo(y1[j].x)); v[j].y = ALPHA * hhi(h0) + (g0 * bfhi(y0[j].x) + g1 * bfhi(y1[j].x));
            v[j].z = ALPHA * hlo(h1) + (g0 * bflo(y0[j].y) + g1 * bflo(y1[j].y)); v[j].w = ALPHA * hhi(h1) + (g0 * bfhi(y0[j].y) + g1 * bfhi(y1[j].y)); }
        if (t + NGW < M) LN2_LOAD(k + 1, t + NGW);
        float mean, rstd; LN_STATS(v, mean, rstd);
#pragma unroll
        for (int j = 0; j < 4; ++j) { v[j] = (v[j] - mean) * rstd * gr[j] + br_[j];
            if (wr32) ((f32x4*)(hout2 + (size_t)t * D))[64 * j + lane] = v[j];
            else { v2u w; w.x = pkh(v[j].x, v[j].y); w.y = pkh(v[j].z, v[j].w); ((v2u*)(hb + (size_t)t * D))[64 * j + lane] = w; } }
    }
#undef LN2_LOAD
}

#ifndef MK_VERIFY
#define MK_VERIFY 0
#endif
__device__ __forceinline__ float bfr(float x) { return bflo(f2bf(x)); }
__device__ __forceinline__ float bfld(const bf16* p) { return bflo((unsigned)*p); }
__device__ __forceinline__ void vfail(unsigned* ctl, int code) { atomicAdd(ctl + 64 + code, 1u); }
__device__ __forceinline__ bool vbad(float ref, float got) { return !(fabsf(ref - got) <= 0.02f * fabsf(ref) + 1e-3f); }

#if MK_VERIFY
constexpr size_t WS_SNAP = 576 * MiB;
__device__ __forceinline__ void verify_phase(const Args& args, int ph, unsigned char* ws, LAS unsigned char* lds, int tid, int bx) {
    unsigned* ctl = (unsigned*)(ws + WS_CTL);
    const float* biasT = (const float*)(ws + WS_BIAS); (void)biasT;
    const bf16* HB = (const bf16*)(ws + WS_HB); const bf16* QB = (const bf16*)(ws + WS_Q); const bf16* KB = (const bf16*)(ws + WS_K); const bf16* VB = (const bf16*)(ws + WS_V); const bf16* AO = (const bf16*)(ws + WS_AO);
    const bf16* YB = (const bf16*)(ws + WS_Y); const bf16* ACT = (const bf16*)(ws + WS_ACT); const bf16* YS = (const bf16*)(ws + WS_YS);
    const int* tok2 = (const int*)(ws + WS_TOK2); const unsigned* ti = (const unsigned*)(ws + WS_TI); const float* snap = (const float*)(ws + WS_SNAP);
    if (ph == 0) { if (bx < 4) vfail(ctl, 40); return; }
    const int l = (ph - 1) / 7, s = (ph - 1) % 7, kind = (l == 1) ? 1 : (l == 2) ? 2 : 0;
    const int kvw = kind == 0 ? 256 : 1024, nqkv = 1024 + 2 * kvw;
    const LayerP& P = args.L[l];
    unsigned* cntw = ctl + CW_CNT + l * 32 * 32;
    const unsigned hs = (unsigned)(bx * 512 + tid) * 2654435761u + (unsigned)l * 977u + (unsigned)s * 131u;
    const int t = (int)(hs % (unsigned)M);
    if (s == 0) {
        const int n = (int)((hs >> 7) % (unsigned)nqkv);
        float a = 0.f; for (int k = 0; k < D; ++k) a += bfld(HB + (size_t)t * D + k) * bfr(P.wqkv[(size_t)k * nqkv + n]);
        float got; if (n < 1024) { a *= 0.125f; got = bfld(QB + (size_t)t * D + n); } else if (n < 1024 + kvw) got = bfld(KB + (size_t)t * kvw + (n - 1024)); else got = bfld(VB + (size_t)t * kvw + (n - 1024 - kvw));
        if (vbad(a, got)) vfail(ctl, l * 8 + 1);
    } else if (s == 1) {
        const int h = (int)((hs >> 7) & 15u), d = (int)((hs >> 11) & 63u), b = t >> 12, pos = t & 4095;
        const bf16* qr = QB + (size_t)t * D + h * HD;
        const int kh = kind == 0 ? (h >> 2) : h;
        const int nk = kind == 0 ? 257 : (kind == 1 ? 387 : 128);
        const int r = pos >> 6, c = pos & 63, rs = r - 4 < 0 ? 0 : (r - 4 > 56 ? 56 : r - 4), cs = c - 8 < 0 ? 0 : (c - 8 > 48 ? 48 : c - 8);
        float mx = kind == 0 ? P.extra[h] : -3.0e38f, den = 0.f, num = 0.f;
        for (int pass = 0; pass < 2; ++pass) {
            for (int i = 0; i < nk; ++i) {
                int j; float bias;
                if (kind == 0) { j = pos - 128 + i; bias = args.t5[t5_bucket(j - pos) * 16 + h]; }
                else if (kind == 1) { const int br = i / 129, mm = i % 129 - 64, dil = br == 0 ? 1 : (br == 1 ? 4 : 16); j = pos + dil * mm; bias = args.t5[t5_bucket(dil * mm) * 16 + h]; }
                else { const int rr = rs + i / 16, cc = cs + i % 16; int dc = cc - c; dc = dc < -15 ? -15 : (dc > 15 ? 15 : dc); j = rr * 64 + cc; bias = P.extra[h * 465 + (rr - r + 7) * 31 + dc + 15]; }
                if (j < 0 || j >= SEQ) continue;
                const bf16* kr = KB + ((size_t)(b * SEQ + j)) * kvw + kh * HD;
                float sc = 0.f; for (int e = 0; e < HD; ++e) sc += bfld(qr + e) * bfld(kr + e);
                sc += bias;
                if (pass == 0) mx = fmaxf(mx, sc);
                else { const float p = expf(sc - mx); den += p; num += p * bfld(VB + ((size_t)(b * SEQ + j)) * kvw + kh * HD + d); }
            }
            if (pass == 0 && kind == 0) den = expf(P.extra[h] - mx);
        }
        if (vbad(num / den, bfld(AO + (size_t)t * D + h * HD + d))) { vfail(ctl, l * 8 + 2);
            if (l == 0) { atomicAdd(ctl + 128, 1u); if (pos < 160 || pos >= SEQ - 160) atomicAdd(ctl + 129, 1u); if (d >= 32) atomicAdd(ctl + 130, 1u); if (d & 4) atomicAdd(ctl + 131, 1u); } }
    } else if (s == 2) {
        const int n = (int)((hs >> 7) % (unsigned)D);
        float a = 0.f; for (int k = 0; k < D; ++k) a += bfld(AO + (size_t)t * D + k) * bfr(P.wo[(size_t)k * D + n]);
        if (vbad(a, bfld(YB + (size_t)t * D + n))) vfail(ctl, l * 8 + 3);
    } else if (s == 3 || s == 6) {
        const float* xin = (s == 3 && l == 0) ? args.x : snap;
        const float* gg = s == 3 ? P.ln1g : P.ln2g; const float* bb = s == 3 ? P.ln1b : P.ln2b;
        const v4u a4 = ((const v4u*)ti)[2 * t]; const f32x2 gq0 = ((const f32x2*)(ti + 8 * M))[t];
        const LAS int* tb = (const LAS int*)(lds + TB_OFF);
        const size_t s0 = (size_t)tb[a4.x & 31] * 256 + a4.z, s1 = (size_t)tb[a4.y & 31] * 256 + a4.w;
        const float g0 = gq0.x, g1 = gq0.y;
        float sum = 0.f;
        for (int d = 0; d < D; ++d) { const float y = s == 3 ? bfld(YB + (size_t)t * D + d) : (g0 * bfld(YS + s0 * D + d) + g1 * bfld(YS + s1 * D + d)); sum += ALPHA * xin[(size_t)t * D + d] + y; }
        const float mean = sum / D; float sq = 0.f;
        for (int d = 0; d < D; ++d) { const float y = s == 3 ? bfld(YB + (size_t)t * D + d) : (g0 * bfld(YS + s0 * D + d) + g1 * bfld(YS + s1 * D + d)); const float v = ALPHA * xin[(size_t)t * D + d] + y - mean; sq += v * v; }
        const float rstd = 1.0f / sqrtf(sq / D + LN_EPS);
        bool bad = false; float lg[4] = {0.f, 0.f, 0.f, 0.f};
        for (int d = 0; d < D; ++d) { const float y = s == 3 ? bfld(YB + (size_t)t * D + d) : (g0 * bfld(YS + s0 * D + d) + g1 * bfld(YS + s1 * D + d));
            const float o = (ALPHA * xin[(size_t)t * D + d] + y - mean) * rstd * gg[d] + bb[d]; const float got = args.out[(size_t)t * D + d];
            if (!(fabsf(o - got) <= 2e-3f)) bad = true; if (vbad(got, bfld(HB + (size_t)t * D + d))) bad = true;
            if (s == 3) { for (int i = 0; i < 4; ++i) lg[i] += got * P.rgw[d * 4 + i]; } }
        if (bad) vfail(ctl, l * 8 + (s == 3 ? 4 : 8));
        if (s == 3) {
            for (int i = 0; i < 4; ++i) lg[i] += P.rgb[i];
            int grp = 0; for (int i = 1; i < 4; ++i) if (lg[i] > lg[grp]) grp = i;
            float gap = 1e30f; for (int i = 0; i < 4; ++i) if (i != grp) gap = fminf(gap, lg[grp] - lg[i]);
            float den = 0.f; for (int i = 0; i < 4; ++i) den += expf(lg[i] - lg[grp]);
            const int e0 = (int)a4.x, e1 = (int)a4.y;
            bool rb = false; int gateok = 1;
            if ((e0 >> 3) != grp || (e1 >> 3) != grp) { if (gap > 1e-3f) { rb = true; } }
            else {
                float le[8]; for (int i = 0; i < 8; ++i) le[i] = 0.f;
                for (int d = 0; d < D; ++d) { const float got = args.out[(size_t)t * D + d]; for (int i = 0; i < 8; ++i) le[i] += got * P.rew[d * 32 + grp * 8 + i]; }
                for (int i = 0; i < 8; ++i) le[i] += P.reb[grp * 8 + i];
                int i0 = 0; for (int i = 1; i < 8; ++i) if (le[i] > le[i0]) i0 = i;
                int i1 = -1; for (int i = 0; i < 8; ++i) if (i != i0 && (i1 < 0 || le[i] > le[i1])) i1 = i;
                float third = -3e38f; for (int i = 0; i < 8; ++i) if (i != i0 && i != i1) third = fmaxf(third, le[i]);
                const bool near = (le[i1] - third < 1e-3f) || (le[i0] - le[i1] < 1e-3f);
                if ((e0 != grp * 8 + i0 || e1 != grp * 8 + i1) && !near) { rb = true; }
                if (e0 == grp * 8 + i0 && e1 == grp * 8 + i1) { const f32x2 gq = ((const f32x2*)(ti + 8 * M))[t]; const float dd = expf(le[i1] - le[i0]), pg = 1.0f / den;
                    if (!(fabsf(gq.x - pg / (1.f + dd)) < 1e-3f) || !(fabsf(gq.y - pg * dd / (1.f + dd)) < 1e-3f)) gateok = 0; }
            }
            if (e0 < 0 || e0 > 31 || e1 < 0 || e1 > 31 || e0 == e1) { rb = true; }
            if (gateok == 0) rb = true;
            if (tok2[(size_t)(e0 & 31) * 32768 + a4.z] != t || tok2[(size_t)(e1 & 31) * 32768 + a4.w] != t) { rb = true; }
            if (rb) vfail(ctl, l * 8 + 5);
        }
    } else if (s == 4) {
        const int ks = (int)((hs >> 5) & 1u), c = (int)((hs >> 7) % (unsigned)DEXP);
        const v4u a4 = ((const v4u*)ti)[2 * t]; const int e = (ks ? (int)a4.y : (int)a4.x) & 31, r = ks ? (int)a4.w : (int)a4.z;
        const size_t slot = (size_t)((const LAS int*)(lds + TB_OFF))[e] * 256 + r;
        float g = 0.f, u = 0.f; for (int k = 0; k < D; ++k) { const float xv = bfld(HB + (size_t)t * D + k); g += xv * bfr(P.wg[((size_t)e * D + k) * DEXP + c]); u += xv * bfr(P.wu[((size_t)e * D + k) * DEXP + c]); }
        const float ref = g / (1.0f + expf(-g)) * u;
        if (r < 0 || r >= ((const LAS int*)(lds + CNT_OFF))[e] || vbad(ref, bfld(ACT + slot * DEXP + c))) vfail(ctl, l * 8 + 6);
    } else if (s == 5) {
        const int ks = (int)((hs >> 5) & 1u), n = (int)((hs >> 7) % (unsigned)D);
        const v4u a4 = ((const v4u*)ti)[2 * t]; const int e = (ks ? (int)a4.y : (int)a4.x) & 31, r = ks ? (int)a4.w : (int)a4.z;
        const size_t slot = (size_t)((const LAS int*)(lds + TB_OFF))[e] * 256 + r;
        float a = 0.f; for (int c = 0; c < DEXP; ++c) a += bfld(ACT + slot * DEXP + c) * bfr(P.wd[((size_t)e * DEXP + c) * D + n]);
        if (vbad(a, bfld(YS + slot * D + n))) vfail(ctl, l * 8 + 7);
    }
    (void)cntw;
}
#endif
#ifndef MK_DUP
#define MK_DUP 0
#endif
#ifndef MK_DRY
#define MK_DRY 0
#endif
#ifndef MK_NOLOAD
#define MK_NOLOAD 0
#endif
#ifndef MK_DUPL
#define MK_DUPL 15
#endif
#ifndef MK_DUPC
#define MK_DUPC 1
#endif
#ifndef MK_MFMA_KINDS
#define MK_MFMA_KINDS 7
#endif
#ifndef PH_MASK
#define PH_MASK 0xff
#endif
#define PH_ON(k) (((PH_MASK) >> (k)) & 1)
#ifndef CV_KA
#define CV_KA 10
#endif
#ifndef CV_KB
#define CV_KB 2
#endif
#define CV_SETUP() do { if (l + 1 < NLAYER) { const int nwg_ = 4 * __builtin_amdgcn_readfirstlane(((const LAS int*)(lds + TB_OFF))[32]); cv_rem = nwg_ % G; cv_nidle = cv_rem ? G - cv_rem : 0; cv_idle = cv_rem != 0 && bx >= cv_rem; \
        const int nit_ = convert_nitems(nqkv_n); cv_na = cv_nidle * NWAVES * CV_KA; if (cv_na > nit_) cv_na = nit_; cv_nb = cv_nidle * NWAVES * CV_KB; if (cv_nb > nit_ - cv_na) cv_nb = nit_ - cv_na; } } while (0)
__global__ void __launch_bounds__(NWAVES * 64, 2) mk_fwd(Args args) {
    extern __shared__ __attribute__((aligned(16))) unsigned char lds_raw[];
    LAS unsigned char* lds = (LAS unsigned char*)lds_raw;
    volatile LAS unsigned* MISC = (volatile LAS unsigned*)(lds + MISC_OFF);
    for (int u = threadIdx.x; u < (LDS_BYTES - LDSCTL_OFF) / 4; u += NWAVES * 64) ((LAS unsigned*)(lds + LDSCTL_OFF))[u] = 0u;
    __syncthreads();
    const int lo = args.ph_lo, hi = args.ph_hi;
    XcdBarrier bar; bar.bar = (unsigned*)(args.ws + WS_CTL) + CW_BAR; bar.x = 0; bar.st = nullptr;
    if (hi - lo > 1) bar = xcd_barrier_post((unsigned*)(args.ws + WS_CTL) + CW_BAR + args.li * XCD_BAR_WORDS, MISC + 8);

    int dup_done = 0; (void)dup_done;
    for (int ph = lo; ph < hi; ++ph) {
        int tid = threadIdx.x; asm volatile("" : "+v"(tid));
        unsigned zoff = 0u; asm volatile("" : "+s"(zoff));
        unsigned char* ws = args.ws + zoff;
        int G = gridDim.x, bx = blockIdx.x; asm volatile("" : "+s"(G), "+s"(bx));
        const int lane = tid & 63, wave = __builtin_amdgcn_readfirstlane(tid >> 6);
        const int vcu = (G % 8 == 0) ? (bx % 8) * (G / 8) + bx / 8 : bx;
        const int gw = vcu * NWAVES + wave, NGW = G * NWAVES;
        unsigned* ctl = (unsigned*)(ws + WS_CTL);
        float* biasT = (float*)(ws + WS_BIAS);
        bf16* HB = (bf16*)(ws + WS_HB); bf16* QB = (bf16*)(ws + WS_Q); bf16* KB = (bf16*)(ws + WS_K); bf16* VB = (bf16*)(ws + WS_V); bf16* AO = (bf16*)(ws + WS_AO);
        bf16* YB = (bf16*)(ws + WS_Y); bf16* ACT = (bf16*)(ws + WS_ACT); bf16* YS = (bf16*)(ws + WS_YS);
        int* tok2 = (int*)(ws + WS_TOK2); unsigned* ti = (unsigned*)(ws + WS_TI);
        if (PH_ON(0) && ph == 0) {
            for (int i = bx * 512 + tid; i < 16 * 2049; i += G * 512) { const int h = i / 2049, rel = i % 2049 - 1024; biasT[i] = args.t5[t5_bucket(rel) * 16 + h]; }
            for (int i = bx * 512 + tid; i < 5 * 16 * AT_STRIDE; i += G * 512) { const int tb_ = i / (16 * AT_STRIDE), hh = (i / AT_STRIDE) % 16, j = i % AT_STRIDE; float v = -1e30f;
                if (tb_ == 0) { const int idx = j - 32; if (idx >= 0 && idx <= 256) v = args.t5[t5_bucket(idx - 128) * 16 + hh] * LOG2E; }
                else if (tb_ < 4) { const int dl_ = tb_ == 1 ? 16 : (tb_ == 2 ? 4 : 1), idx = j - 32; if (idx >= 0 && idx <= 128) v = args.t5[t5_bucket(dl_ * (idx - 64)) * 16 + hh] * LOG2E; }
                else { const int idx = j - 16; if (idx >= 0 && idx < 465) v = args.L[2].extra[hh * 465 + idx] * LOG2E; }
                ((float*)(ws + WS_BIAS + 256 * 1024))[i] = v; }
            for (size_t i = (size_t)bx * 512 + tid; i < (size_t)M * D / 8; i += (size_t)G * 512) { const f32x4 a = __builtin_nontemporal_load(&((const f32x4*)args.x)[2 * i]), b = __builtin_nontemporal_load(&((const f32x4*)args.x)[2 * i + 1]);
                v4u w; w.x = pkh(a.x, a.y); w.y = pkh(a.z, a.w); w.z = pkh(b.x, b.y); w.w = pkh(b.z, b.w); ((v4u*)HB)[i] = w; }
            for (int rc = 0; rc < MK_DUPC; ++rc) convert_layer_weights(args.L[0], 1536, ws + WSET2_OFF, lds, gw, NGW, 0, convert_nitems(1536), wave, lane);
        } else {
            const int l = (ph - 1) / 7, s = (ph - 1) % 7, kind = (l == 1) ? 1 : (l == 2) ? 2 : 0;
            const int kvw = kind == 0 ? 256 : 1024, nqkv = 1024 + 2 * kvw;
            const LayerP& P = args.L[l];
            unsigned* cntw = ctl + CW_CNT + l * 32 * 32;
            const size_t wofs = (l & 1) ? 0 : WSET2_OFF, wofs_n = (l & 1) ? WSET2_OFF : 0;
            const int nqkv_n = (l + 1 == 1 || l + 1 == 2) ? 3072 : 1536;
            int cv_rem = 0, cv_nidle = 0, cv_na = 0, cv_nb = 0; bool cv_idle = false;
            if (PH_ON(1) && s == 0) {
                pg8::StaticOrder S; S.init(M / 256, nqkv / 256, G, bx);
                pg8::EpiQKV E{QB, KB, VB, kvw, 0.125f};
                pg8::gemm_phase<pg8::EpiQKV, pg8::StaticOrder, false, true, true>(tid, lds + RING_OFF, HB, (const bf16*)(ws + wofs + WS_WQKV), D, 0, nullptr, S, E);
            } else if (PH_ON(2) && s == 1) {
                bf16* OB = (bf16*)(ws + WS_OB); float* LSE = (float*)(ws + WS_LSE); const int sub = args.pad;
#if MK_DRYA
                if (kind == 0) attn_phase_mfma<0, 0, (MK_DRYA == 2)>(QB, KB, VB, biasT, P.extra, (bf16*)(ws + 720 * MiB), OB, LSE, 0, 1, lds, gw, NGW, wave, lane);
#endif
                if (kind == 0) { if (MK_MFMA_KINDS & 1) attn_coop_phase<0, 0>(QB, KB, VB, biasT, P.extra, AO, OB, LSE, 0, 1, lds, tid, vcu, G, wave, lane); else attnA_naive(QB, KB, VB, P.extra, biasT, AO, gw, NGW, lane); }
                else if (kind == 2) { if (MK_MFMA_KINDS & 4) { if (MK_COOPC) attn_coopC_phase(QB, KB, VB, biasT, AO, lds, tid, vcu, G, wave, lane); else attn_phase_mfma<2, 0>(QB, KB, VB, biasT, P.extra, AO, OB, LSE, 0, 1, lds, gw, NGW, wave, lane); } else attnC_naive(QB, KB, VB, P.extra, AO, gw, NGW, lane); }
                else if (MK_MFMA_KINDS & 2) {
                    const int nol_ = (MK_NOLOAD && MK_DUP && !dup_done) ? 1 : 0;
                    if (sub != 2) { attn_coop_phase<1, 1>(QB, KB, VB, biasT, nullptr, AO, OB, LSE, 0, 16, lds, tid, vcu, G, wave, lane, nol_);
                                    attn_coop_phase<1, 1>(QB, KB, VB, biasT, nullptr, AO, OB, LSE, 1, 4, lds, tid, vcu, G, wave, lane, nol_); }
                    if (sub == 0) xcd_barrier(bar);
                    if (sub != 1) attn_coop_phase<1, 2>(QB, KB, VB, biasT, nullptr, AO, OB, LSE, 0, 1, lds, tid, vcu, G, wave, lane, nol_);
                } else attnB_naive(QB, KB, VB, biasT, AO, gw, NGW, lane);
            } else if (PH_ON(3) && s == 2) {
                pg8::StaticOrder S; S.init(M / 256, D / 256, G, bx);
                pg8::EpiPlain E{YB, D};
                pg8::gemm_phase<pg8::EpiPlain, pg8::StaticOrder, false, true, false, M>(tid, lds + RING_OFF, AO, (const bf16*)(ws + wofs + WS_WO), D, 0, nullptr, S, E);
            } else if (PH_ON(4) && s == 3) {
{ const bool dry = ((MK_DUP >> 3) & 1) && !dup_done;
                  ln1_router_phase(HB, YB, P, dry ? (bf16*)(ws + 848 * MiB) : HB, dry ? ctl + 32768 : cntw,
                                   dry ? (int*)(ws + 912 * MiB) : tok2, dry ? (unsigned*)(ws + 916 * MiB) : ti, lds, tid, vcu, G, lane, wave); }
            } else if (PH_ON(5) && s == 4) {
                build_moe_tables(cntw, lds, tid);
                CV_SETUP();
                pg8::MoeOrder S; S.tb = (const LAS int*)(lds + TB_OFF); S.cnt = (const LAS int*)(lds + CNT_OFF); S.te = (const LAS unsigned*)(lds + TE_OFF);
                S.so.init(__builtin_amdgcn_readfirstlane(S.tb[32]), 4, G, bx);
                pg8::EpiSilu E{ACT};
                pg8::gemm_phase<pg8::EpiSilu, pg8::MoeOrder, true, true, true>(tid, lds + RING_OFF, HB, (const bf16*)(ws + wofs + WS_W1), D, (size_t)D * D, tok2, S, E);
                if (l + 1 < NLAYER && cv_idle) convert_layer_weights(args.L[l + 1], nqkv_n, ws + wofs_n, lds, (bx - cv_rem) * NWAVES + wave, cv_nidle * NWAVES, 0, cv_na, wave, lane);
            } else if (PH_ON(6) && s == 5) {
                if (ph == lo || MK_DUP) build_moe_tables(cntw, lds, tid);
                CV_SETUP();
                pg8::MoeOrder S; S.tb = (const LAS int*)(lds + TB_OFF); S.cnt = (const LAS int*)(lds + CNT_OFF); S.te = (const LAS unsigned*)(lds + TE_OFF);
                S.so.init(__builtin_amdgcn_readfirstlane(S.tb[32]), 4, G, bx);
                pg8::EpiPlain E{YS, D};
                pg8::gemm_phase<pg8::EpiPlain, pg8::MoeOrder, false, true, false, pg8::ACT_SLOTS>(tid, lds + RING_OFF, ACT, (const bf16*)(ws + wofs + WS_W2), DEXP, (size_t)D * DEXP, nullptr, S, E);
                if (l + 1 < NLAYER && cv_idle) convert_layer_weights(args.L[l + 1], nqkv_n, ws + wofs_n, lds, (bx - cv_rem) * NWAVES + wave, cv_nidle * NWAVES, cv_na, cv_na + cv_nb, wave, lane);
            } else if (PH_ON(7)) {
                if (ph == lo || MK_DUP) build_moe_tables(cntw, lds, tid);
                CV_SETUP();
#if MK_DRY & 2
                ln2_combine_phase(HB, (float*)(ws + 720 * MiB), l == NLAYER - 1, YS, P, (bf16*)(ws + 848 * MiB), ti, lds, gw, NGW, lane);
#endif
                ln2_combine_phase(HB, args.out, l == NLAYER - 1, YS, P, HB, ti, lds, gw, NGW, lane);
                if (l + 1 < NLAYER) { __syncthreads(); for (int rc = 0; rc < MK_DUPC; ++rc) convert_layer_weights(args.L[l + 1], nqkv_n, ws + wofs_n, lds, gw, NGW, cv_na + cv_nb, convert_nitems(nqkv_n), wave, lane); }
            }
        }
        if (ph + 1 < hi) xcd_barrier(bar);
        if (MK_DUP) { if (ph > 0 && ((MK_DUP >> ((ph - 1) % 7)) & 1) && ((MK_DUPL >> ((ph - 1) / 7)) & 1) && !dup_done) { dup_done = 1; --ph; } else dup_done = 0; }
    }
}

#if MK_VERIFY
__global__ void __launch_bounds__(NWAVES * 64) mk_verify(Args args) {
    extern __shared__ __attribute__((aligned(16))) unsigned char lds_raw[];
    LAS unsigned char* lds = (LAS unsigned char*)lds_raw;
    const int ph = args.ph_lo;
    if (ph == 63) { if (blockIdx.x == 0 && threadIdx.x == 0) { int code = 0; for (int c = 63; c >= 1; --c) if (__hip_atomic_load((unsigned*)(args.ws + WS_CTL) + 64 + c, RLX_AGENT) > 1000u) code = c; if (code == 2) { const float F = (float)__hip_atomic_load((unsigned*)(args.ws + WS_CTL) + 128, RLX_AGENT); int e = 8;
            for (int q = 0; q < 3; ++q) { const float fr = (float)__hip_atomic_load((unsigned*)(args.ws + WS_CTL) + 129 + q, RLX_AGENT) / F; e += (fr < 0.15f ? 0 : (fr < 0.4f ? 1 : (fr < 0.6f ? 2 : 3))) << (2 * q); }
            args.out[0] = exp2f((float)e); }
        else if (code) args.out[0] = exp2f((float)(code + 2)); } return; }
    const int vp = ph - 64;
    if (vp > 0) { const int l_ = (vp - 1) / 7, s_ = (vp - 1) % 7; if (s_ >= 3) build_moe_tables((unsigned*)(args.ws + WS_CTL) + CW_CNT + l_ * 32 * 32, lds, (int)threadIdx.x); }
    verify_phase(args, vp, args.ws, lds, (int)threadIdx.x, (int)blockIdx.x);
}
#endif
extern "C" void kernel_launch(void* const* d_in, const int* in_sizes, int n_in, void* d_out, int out_size, void* d_ws, size_t ws_size, hipStream_t stream) {
    static int grid = 0;
    if (grid == 0) {
        if (n_in != 57 || in_sizes[0] != M * D || out_size != M * D || ws_size < ((MK_DRY || MK_DRYA) ? 920 * MiB : (672 * MiB) + (MK_VERIFY ? 144 * MiB : 0))) { fprintf(stderr, "kernel_launch: unexpected shapes (n_in %d, in0 %d, out %d, ws %zu); nothing launched\n", n_in, n_in > 0 ? in_sizes[0] : -1, out_size, ws_size); grid = -1; return; }
        int dev = 0, cus = 0, per_cu = 0;
        if (hipGetDevice(&dev) != hipSuccess || hipDeviceGetAttribute(&cus, hipDeviceAttributeMultiprocessorCount, dev) != hipSuccess) { grid = -1; return; }
#if MK_VERIFY
        (void)hipFuncSetAttribute((const void*)mk_verify, hipFuncAttributeMaxDynamicSharedMemorySize, LDS_BYTES);
#endif
        if (hipFuncSetAttribute((const void*)mk_fwd, hipFuncAttributeMaxDynamicSharedMemorySize, LDS_BYTES) != hipSuccess) { fprintf(stderr, "kernel_launch: hipFuncSetAttribute failed\n"); grid = -1; return; }
        if (hipOccupancyMaxActiveBlocksPerMultiprocessor(&per_cu, (const void*)mk_fwd, NWAVES * 64, LDS_BYTES) != hipSuccess || per_cu < 1) { fprintf(stderr, "kernel_launch: occupancy query says %d blocks/CU\n", per_cu); }
        (void)hipGetLastError();
        grid = cus;
    }
    if (grid < 0) return;
    const size_t ws_used = 672 * MiB;
    unsigned char* wsb = (unsigned char*)d_ws + (ws_size > ws_used ? ((ws_size - ws_used) / (2 * MiB)) * (2 * MiB) : 0);
    (void)hipMemsetAsync((char*)wsb + WS_CTL, 0, CTL_ZERO_BYTES, stream);
    Args a{};
    a.x = (const float*)d_in[0]; a.t5 = (const float*)d_in[1];
    int k = 2;
    for (int l = 0; l < NLAYER; ++l) {
        const int kind = (l == 1) ? 1 : (l == 2) ? 2 : 0; LayerP& P = a.L[l];
        P.wqkv = (const float*)d_in[k++];
        P.extra = (kind == 1) ? nullptr : (const float*)d_in[k++];
        P.wo = (const float*)d_in[k++]; P.ln1g = (const float*)d_in[k++]; P.ln1b = (const float*)d_in[k++];
        P.rgw = (const float*)d_in[k++]; P.rgb = (const float*)d_in[k++]; P.rew = (const float*)d_in[k++]; P.reb = (const float*)d_in[k++];
        P.wg = (const float*)d_in[k++]; P.wu = (const float*)d_in[k++]; P.wd = (const float*)d_in[k++]; P.ln2g = (const float*)d_in[k++]; P.ln2b = (const float*)d_in[k++];
    }
    a.out = (float*)d_out; a.ws = wsb;
#if MK_VERIFY
    for (int ph = 0; ph <= NPHASE; ++ph) {
        if (ph < NPHASE) {
            const int s_ = ph ? (ph - 1) % 7 : -1, l_ = ph ? (ph - 1) / 7 : 0;
            if ((s_ == 3 && l_ > 0) || s_ == 6) (void)hipMemcpyAsync((char*)d_ws + WS_SNAP, d_out, (size_t)M * D * 4, hipMemcpyDeviceToDevice, stream);
            a.ph_lo = ph; a.ph_hi = ph + 1; a.li = 0;
            if (s_ == 1 && l_ == 1) { a.pad = 1; hipLaunchKernelGGL(mk_fwd, dim3(grid), dim3(NWAVES * 64), LDS_BYTES, stream, a); a.pad = 2; }
            hipLaunchKernelGGL(mk_fwd, dim3(grid), dim3(NWAVES * 64), LDS_BYTES, stream, a); a.pad = 0;
            a.ph_lo = 64 + ph; a.ph_hi = 65 + ph;
            hipLaunchKernelGGL(mk_verify, dim3(grid), dim3(NWAVES * 64), LDS_BYTES, stream, a);
        } else { a.ph_lo = 63; a.ph_hi = 64; hipLaunchKernelGGL(mk_verify, dim3(grid), dim3(NWAVES * 64), LDS_BYTES, stream, a); }
    }
#else
    constexpr int NL = MK_N_LAUNCHES;
    for (int li = 0; li < NL; ++li) {
        a.ph_lo = (NL == NPHASE) ? li : (li * NPHASE) / NL; a.ph_hi = (NL == NPHASE) ? li + 1 : ((li + 1) * NPHASE) / NL; a.li = li;
        hipLaunchKernelGGL(mk_fwd, dim3(grid), dim3(NWAVES * 64), LDS_BYTES, stream, a);
        const hipError_t le = hipPeekAtLastError();
        if (le != hipSuccess) { fprintf(stderr, "kernel_launch: launch %d failed: %s\n", li, hipGetErrorName(le)); break; }
    }
#endif
}
```
